# Optimizing an MI355X kernel written in HIP

```python
import math
import jax, jax.numpy as jnp
from jax import lax
import numpy as np

D_MODEL = 1024
BATCH = 8
SEQ = 2048
DEPTH = 4
DEC_BATCH = 128
DEC_SEQ = 4
PAST_LEN = 2048
PAGE_SIZE = 128

N_MIXERS = 3
N_LAYERS_A = (DEPTH + 2) // 3
N_LAYERS_B = (DEPTH + 1) // 3
N_LAYERS_C = DEPTH // 3

POOL_WINDOWS = (2, 4, 8, 16)
POOL_GROUPS = len(POOL_WINDOWS)
POOL_GROUP_DIM = D_MODEL // POOL_GROUPS
POOL_STATE_ROWS = max(POOL_WINDOWS) - 1

DILATED_GROUPS = ((128, 1), (512, 4), (2048, 16))
N_DIL_GROUPS = len(DILATED_GROUPS)
HEADS_PER_GROUP = 4
HEAD_DIM = 64
N_HEADS_B = N_DIL_GROUPS * HEADS_PER_GROUP
ATTN_INNER = N_HEADS_B * HEAD_DIM
QUERY_BLOCK = 128
NUM_BUCKETS = 32
MAX_DISTANCE = 2048

GLA_HEADS = 4
GLA_DK = D_MODEL // (2 * GLA_HEADS)
GLA_DV = D_MODEL // GLA_HEADS
GLA_QK_WIDTH = GLA_HEADS * GLA_DK
GLA_V_WIDTH = GLA_HEADS * GLA_DV
GATE_RANK = 16
GATE_TAU = 16.0
GLA_CHUNK = 64
GLA_IN_WIDTH = 2 * GLA_QK_WIDTH + 2 * GLA_V_WIDTH + GATE_RANK

D_FF = 128 * ((8 * D_MODEL // 3 + 127) // 128)
CONV_WIDTH = 3

N_MOD = 6
EPS = 1e-6
NEG_INF = -1e30

kernel_name = 'hybrid_pool_dilated_gla_step'


def rms_norm(x, gain):
    xf = x.astype(jnp.float32)
    y = xf * lax.rsqrt(jnp.mean(xf * xf, axis=-1, keepdims=True) + EPS)
    return (y * gain.astype(jnp.float32)).astype(x.dtype)


def t5_bucket(dist):
    max_exact = NUM_BUCKETS // 2
    d_f = jnp.maximum(dist, 1).astype(jnp.float32)
    large = max_exact + (jnp.log(d_f / max_exact) / math.log(MAX_DISTANCE / max_exact)
                         * (NUM_BUCKETS - max_exact)).astype(jnp.int32)
    large = jnp.minimum(large, NUM_BUCKETS - 1)
    return jnp.where(dist < max_exact, dist, large)


def pool_mixer(u, past, pos0, w_group, layer_scale):
    B, T, _ = u.shape
    P = past.shape[1]
    u_all = jnp.concatenate([past.astype(u.dtype), u], axis=1)
    uf = u_all.astype(jnp.float32)
    cs = jnp.concatenate([jnp.zeros((B, 1, D_MODEL), jnp.float32), jnp.cumsum(uf, axis=1)], axis=1)
    rows = P + jnp.arange(T)
    pos = pos0 + jnp.arange(T)
    hi = cs[:, P + 1:]
    means = []
    for g, w in enumerate(POOL_WINDOWS):
        sl = slice(g * POOL_GROUP_DIM, (g + 1) * POOL_GROUP_DIM)
        lo = jnp.maximum(rows + 1 - w, 0)
        count = jnp.minimum(pos + 1, w).astype(jnp.float32)
        means.append((hi[:, :, sl] - cs[:, lo, sl]) / count[None, :, None])
    d = jnp.concatenate(means, axis=-1) - uf[:, P:]
    y = jnp.einsum('btgc,gce->btge', d.reshape(B, T, POOL_GROUPS, POOL_GROUP_DIM),
                   w_group.astype(jnp.float32))
    y = y.reshape(B, T, D_MODEL) * layer_scale.astype(jnp.float32)
    keep = min(POOL_STATE_ROWS, P + T)
    return y.astype(u.dtype), u_all[:, P + T - keep:]


def dilated_group_attention(q, k_all, v_all, p_past, dilation, window, bias):
    B, Tq, H, Dh = q.shape
    nk = window // dilation + 1
    offs = jnp.arange(nk) * dilation
    qb = math.gcd(Tq, QUERY_BLOCK)
    nb = Tq // qb
    q_blocks = q.reshape(B, nb, qb, H, Dh).swapaxes(0, 1)
    bias_f = bias.astype(jnp.float32)[None, :, None, :]

    def one_block(args):
        blk, qblk = args
        rows = p_past + blk * qb + jnp.arange(qb)
        idx = rows[:, None] - offs[None, :]
        valid = idx >= 0
        idx_c = jnp.maximum(idx, 0)
        kg = k_all[:, idx_c]
        vg = v_all[:, idx_c]
        logits = jnp.einsum('bqhd,bqkhd->bhqk', qblk, kg, preferred_element_type=jnp.float32)
        logits = logits * (HEAD_DIM ** -0.5) + bias_f
        logits = jnp.where(valid[None, None], logits, NEG_INF)
        lse = jax.nn.logsumexp(logits, axis=-1)
        p = jnp.exp(logits - lse[..., None])
        out = jnp.einsum('bhqk,bqkhd->bqhd', p.astype(vg.dtype), vg)
        return out, lse.transpose(0, 2, 1)

    outs, lses = lax.map(one_block, (jnp.arange(nb), q_blocks))
    out = outs.swapaxes(0, 1).reshape(B, Tq, H, Dh)
    lse = lses.swapaxes(0, 1).reshape(B, Tq, H)
    return out, lse


def dilated_attention_mixer(h, pasts, w_in, w_out, rel_bias):
    B, T, _ = h.shape
    qkv = (h @ w_in).reshape(B, T, 3, N_DIL_GROUPS, HEADS_PER_GROUP, HEAD_DIM)
    outs, lses, new_bufs = [], [], []
    for g, (window, dil) in enumerate(DILATED_GROUPS):
        past = pasts[g].astype(h.dtype)
        P = past.shape[1]
        kv_all = jnp.concatenate([past, qkv[:, :, 1:, g].astype(h.dtype)], axis=1)
        buckets = t5_bucket(jnp.arange(window // dil + 1) * dil)
        bias = rel_bias[buckets][:, g * HEADS_PER_GROUP:(g + 1) * HEADS_PER_GROUP].T
        o, lse = dilated_group_attention(qkv[:, :, 0, g], kv_all[:, :, 0], kv_all[:, :, 1], P, dil, window, bias)
        outs.append(o)
        lses.append(lse)
        keep = min(window, P + T)
        new_bufs.append(kv_all[:, P + T - keep:])
    alpha = jax.nn.softmax(jnp.stack(lses, axis=2), axis=2)
    o_all = jnp.stack(outs, axis=2) * alpha[..., None].astype(h.dtype)
    return o_all.reshape(B, T, ATTN_INNER) @ w_out, new_bufs


def gla_mixer(h, S0, w_in, w_gate_up, b_gate, norm_gain, w_out):
    B, T, _ = h.shape
    proj = h @ w_in
    q, k, v, r, gd = jnp.split(proj, [GLA_QK_WIDTH, 2 * GLA_QK_WIDTH, 2 * GLA_QK_WIDTH + GLA_V_WIDTH,
                                      2 * GLA_QK_WIDTH + 2 * GLA_V_WIDTH], axis=-1)
    q = q.reshape(B, T, GLA_HEADS, GLA_DK).astype(jnp.float32) * (GLA_DK ** -0.5)
    k = k.reshape(B, T, GLA_HEADS, GLA_DK).astype(jnp.float32)
    v = v.reshape(B, T, GLA_HEADS, GLA_DV).astype(jnp.float32)
    log_a = jax.nn.log_sigmoid((gd @ w_gate_up + b_gate).astype(jnp.float32)) / GATE_TAU
    log_a = log_a.reshape(B, T, GLA_HEADS, GLA_DK)
    C = math.gcd(T, GLA_CHUNK)
    nc = T // C

    def to_chunks(a):
        return a.reshape(B, nc, C, *a.shape[2:]).swapaxes(0, 1)

    causal = jnp.tril(jnp.ones((C, C), dtype=bool))

    def step(S, inp):
        qc, kc, vc, gc = inp
        b = jnp.cumsum(gc, axis=1)
        o_inter = jnp.einsum('bthk,bhkv->bthv', qc * jnp.exp(b), S)
        diff = b[:, :, None] - b[:, None, :]
        decay = jnp.exp(jnp.where(causal[None, :, :, None, None], diff, -jnp.inf))
        att = jnp.einsum('bthk,bshk,btshk->bhts', qc, kc, decay)
        o_intra = jnp.einsum('bhts,bshv->bthv', att, vc)
        b_end = b[:, -1]
        S_new = jnp.exp(b_end)[..., None] * S + jnp.einsum('bshk,bshv->bhkv', kc * jnp.exp(b_end[:, None] - b), vc)
        return S_new, o_inter + o_intra

    S_fin, o = lax.scan(step, S0.astype(jnp.float32), (to_chunks(q), to_chunks(k), to_chunks(v), to_chunks(log_a)))
    o = o.swapaxes(0, 1).reshape(B, T, GLA_HEADS, GLA_DV)
    o = o * lax.rsqrt(jnp.mean(o * o, axis=-1, keepdims=True) + EPS)
    o = o.reshape(B, T, GLA_V_WIDTH) * norm_gain.astype(jnp.float32)
    out = (o.astype(h.dtype) * jax.nn.silu(r)) @ w_out
    return out, S_fin


def conv_ffn(h, past, w_in, conv_w, conv_b, w_down):
    T = h.shape[1]
    g, u = jnp.split(h @ w_in, 2, axis=-1)
    g_all = jnp.concatenate([past.astype(g.dtype), g], axis=1)
    gc = conv_w[0] * g_all[:, 0:T] + conv_w[1] * g_all[:, 1:T + 1] + conv_w[2] * g_all[:, 2:T + 2] + conv_b
    y = (jax.nn.gelu(gc, approximate=False) * u) @ w_down
    return y, g_all[:, -(CONV_WIDTH - 1):]


def trunk(x, c, pos0, pool_past, win_past1, win_past2, win_past3, gla_past, conv_past,
          w_ada, b_ada, norm_gain, final_gain, rel_bias, pool_w, pool_scale,
          attn_w_in, attn_w_out, gla_w_in, gla_w_gate_up, gla_b_gate, gla_norm_gain, gla_w_out,
          ffn_w_in, ffn_conv_w, ffn_conv_b, ffn_w_down):
    B = x.shape[0]
    c_act = jax.nn.silu(c)
    new_pool, new_w1, new_w2, new_w3, new_gla, new_conv = [], [], [], [], [], []
    for i in range(DEPTH):
        kind, j = i % N_MIXERS, i // N_MIXERS
        mod = (c_act @ w_ada[i] + b_ada[i]).reshape(B, N_MOD, 1, D_MODEL)
        shift1, scale1, gate1, shift2, scale2, gate2 = (mod[:, m] for m in range(N_MOD))
        h = rms_norm(x, norm_gain[i, 0]) * (1 + scale1) + shift1
        if kind == 0:
            mix, st = pool_mixer(h, pool_past[j], pos0, pool_w[j], pool_scale[j])
            new_pool.append(st)
        elif kind == 1:
            mix, bufs = dilated_attention_mixer(h, (win_past1[j], win_past2[j], win_past3[j]),
                                                attn_w_in[j], attn_w_out[j], rel_bias)
            new_w1.append(bufs[0])
            new_w2.append(bufs[1])
            new_w3.append(bufs[2])
        else:
            mix, st = gla_mixer(h, gla_past[j], gla_w_in[j], gla_w_gate_up[j], gla_b_gate[j],
                                gla_norm_gain[j], gla_w_out[j])
            new_gla.append(st)
        x = x + gate1 * mix
        h = rms_norm(x, norm_gain[i, 1]) * (1 + scale2) + shift2
        f, st = conv_ffn(h, conv_past[i], ffn_w_in[i], ffn_conv_w[i], ffn_conv_b[i], ffn_w_down[i])
        new_conv.append(st)
        x = x + gate2 * f
    y = rms_norm(x, final_gain)
    return (y, jnp.stack(new_pool), jnp.stack(new_w1), jnp.stack(new_w2), jnp.stack(new_w3),
            jnp.stack(new_gla), jnp.stack(new_conv))


def setup_inputs(seed: int = 0) -> dict:
    key = jax.random.key(seed)
    ks = jax.random.split(key, 32)

    def nrm(k, shape, s):
        return jax.random.normal(k, shape, jnp.float32) * s

    win_rows = [min(w, PAST_LEN) for (w, _) in DILATED_GROUPS]
    return {
        'x_prompt': nrm(ks[0], (BATCH, SEQ, D_MODEL), 1.0),
        'x_sample': nrm(ks[1], (DEC_BATCH, DEC_SEQ, D_MODEL), 1.0),
        'state_pool': nrm(ks[2], (N_LAYERS_A, DEC_BATCH, POOL_STATE_ROWS, D_MODEL), 1.0),
        'cache_win_g1': nrm(ks[3], (N_LAYERS_B, DEC_BATCH, win_rows[0], 2, HEADS_PER_GROUP, HEAD_DIM), 1.0),
        'cache_win_g2': nrm(ks[4], (N_LAYERS_B, DEC_BATCH, win_rows[1], 2, HEADS_PER_GROUP, HEAD_DIM), 1.0),
        'cache_win_g3': nrm(ks[5], (N_LAYERS_B, DEC_BATCH, win_rows[2], 2, HEADS_PER_GROUP, HEAD_DIM), 1.0),
        'state_gla': nrm(ks[6], (N_LAYERS_C, DEC_BATCH, GLA_HEADS, GLA_DK, GLA_DV), 1.0),
        'state_ffn_conv': nrm(ks[7], (DEPTH, DEC_BATCH, CONV_WIDTH - 1, D_FF), 1.0),
        'c_prompt': nrm(ks[8], (BATCH, D_MODEL), 1.0),
        'c_sample': nrm(ks[9], (DEC_BATCH, D_MODEL), 1.0),
        'w_ada': nrm(ks[10], (DEPTH, D_MODEL, N_MOD * D_MODEL), 0.3 * D_MODEL ** -0.5),
        'b_ada': nrm(ks[11], (DEPTH, N_MOD * D_MODEL), 0.02),
        'norm_gain': 1.0 + nrm(ks[12], (DEPTH, 2, D_MODEL), 0.05),
        'final_gain': 1.0 + nrm(ks[13], (D_MODEL,), 0.05),
        'rel_bias': nrm(ks[14], (NUM_BUCKETS, N_HEADS_B), 0.5),
        'pool_w': nrm(ks[15], (N_LAYERS_A, POOL_GROUPS, POOL_GROUP_DIM, POOL_GROUP_DIM), POOL_GROUP_DIM ** -0.5),
        'pool_scale': 1.0 + nrm(ks[16], (N_LAYERS_A, D_MODEL), 0.05),
        'attn_w_in': nrm(ks[17], (N_LAYERS_B, D_MODEL, 3 * ATTN_INNER), D_MODEL ** -0.5),
        'attn_w_out': nrm(ks[18], (N_LAYERS_B, ATTN_INNER, D_MODEL), ATTN_INNER ** -0.5),
        'gla_w_in': nrm(ks[19], (N_LAYERS_C, D_MODEL, GLA_IN_WIDTH), D_MODEL ** -0.5),
        'gla_w_gate_up': nrm(ks[20], (N_LAYERS_C, GATE_RANK, GLA_QK_WIDTH), GATE_RANK ** -0.5),
        'gla_b_gate': nrm(ks[21], (N_LAYERS_C, GLA_QK_WIDTH), 0.1),
        'gla_norm_gain': 1.0 + nrm(ks[22], (N_LAYERS_C, GLA_V_WIDTH), 0.05),
        'gla_w_out': nrm(ks[23], (N_LAYERS_C, GLA_V_WIDTH, D_MODEL), GLA_V_WIDTH ** -0.5),
        'ffn_w_in': nrm(ks[24], (DEPTH, D_MODEL, 2 * D_FF), D_MODEL ** -0.5),
        'ffn_conv_w': nrm(ks[25], (DEPTH, CONV_WIDTH, D_FF), CONV_WIDTH ** -0.5),
        'ffn_conv_b': nrm(ks[26], (DEPTH, D_FF), 0.02),
        'ffn_w_down': nrm(ks[27], (DEPTH, D_FF, D_MODEL), D_FF ** -0.5),
    }


def reference(x_prompt, x_sample, state_pool, cache_win_g1, cache_win_g2, cache_win_g3, state_gla, state_ffn_conv,
              c_prompt, c_sample, w_ada, b_ada, norm_gain, final_gain, rel_bias, pool_w, pool_scale,
              attn_w_in, attn_w_out, gla_w_in, gla_w_gate_up, gla_b_gate, gla_norm_gain, gla_w_out,
              ffn_w_in, ffn_conv_w, ffn_conv_b, ffn_w_down):
    weights = (w_ada, b_ada, norm_gain, final_gain, rel_bias, pool_w, pool_scale,
               attn_w_in, attn_w_out, gla_w_in, gla_w_gate_up, gla_b_gate, gla_norm_gain, gla_w_out,
               ffn_w_in, ffn_conv_w, ffn_conv_b, ffn_w_down)
    dt = x_prompt.dtype
    empty_pool = jnp.zeros((N_LAYERS_A, BATCH, 0, D_MODEL), dt)
    empty_win = jnp.zeros((N_LAYERS_B, BATCH, 0, 2, HEADS_PER_GROUP, HEAD_DIM), dt)
    zero_gla = jnp.zeros((N_LAYERS_C, BATCH, GLA_HEADS, GLA_DK, GLA_DV), jnp.float32)
    zero_conv = jnp.zeros((DEPTH, BATCH, CONV_WIDTH - 1, D_FF), dt)
    (y_prompt, pool_p, win1_p, win2_p, win3_p, gla_p, conv_p) = trunk(
        x_prompt, c_prompt, 0, empty_pool, empty_win, empty_win, empty_win, zero_gla, zero_conv, *weights)
    (y_sample, pool_s, win1_s, win2_s, win3_s, gla_s, conv_s) = trunk(
        x_sample, c_sample, PAST_LEN, state_pool, cache_win_g1, cache_win_g2, cache_win_g3, state_gla,
        state_ffn_conv, *weights)
    return (y_prompt, y_sample, pool_p, pool_s, win1_p, win1_s, win2_p, win2_s, win3_p, win3_s,
            gla_p, gla_s, conv_p, conv_s)
```

```cpp
#include <hip/hip_runtime.h>
#include <cstdio>
#include <cstdint>

#ifndef MK_LAUNCH_PER_PHASE
#define MK_LAUNCH_PER_PHASE 0
#endif

constexpr int D = 1024, MP = 16384, MS = 512, M = MP + MS, TP = 2048, NBP = 8, NBS = 128, DFF = 2816, NBI = 136;
constexpr int MODLD = 24576;
constexpr int NWNF = 28160;
constexpr float EPS = 1e-6f;

#define GAS __attribute__((address_space(1)))
#define LAS __attribute__((address_space(3)))
typedef unsigned short bf16;
typedef unsigned v4u __attribute__((ext_vector_type(4)));
typedef unsigned v2u __attribute__((ext_vector_type(2)));
typedef float f32x4 __attribute__((ext_vector_type(4)));
typedef float f32x2 __attribute__((ext_vector_type(2)));
typedef short bf16x8 __attribute__((ext_vector_type(8)));
typedef __bf16 hbf2 __attribute__((ext_vector_type(2)));
#define LDS_WAIT() asm volatile("s_waitcnt lgkmcnt(0)" ::: "memory")
#define VM_WAIT() asm volatile("s_waitcnt vmcnt(0)" ::: "memory")
__device__ __forceinline__ unsigned pk2(float lo, float hi) { f32x2 v = {lo, hi}; return __builtin_bit_cast(unsigned, __builtin_convertvector(v, hbf2)); }
__device__ __forceinline__ float bf2f(unsigned short b) { return __builtin_bit_cast(float, ((unsigned)b) << 16); }
__device__ __forceinline__ float bflo(unsigned w) { return __builtin_bit_cast(float, w << 16); }
__device__ __forceinline__ float bfhi(unsigned w) { return __builtin_bit_cast(float, w & 0xffff0000u); }
__device__ __forceinline__ float wave_sum(float v) {
#pragma unroll
    for (int o = 1; o < 64; o <<= 1) v += __shfl_xor(v, o);
    return v;
}
__device__ __forceinline__ int batch_of_row(int r) { return r < MP ? (r >> 11) : NBP + ((r - MP) >> 2); }

__device__ __forceinline__ int fresh_lane() { int l = (int)__builtin_amdgcn_mbcnt_hi(~0u, __builtin_amdgcn_mbcnt_lo(~0u, 0u)); asm volatile("" : "+v"(l)); return l; }
#define MFMA16(a, b, c) __builtin_amdgcn_mfma_f32_16x16x32_bf16((a), (b), (c), 0, 0, 0)
#define LDS_BARRIER() do { asm volatile("s_waitcnt lgkmcnt(0)" ::: "memory"); __builtin_amdgcn_s_barrier(); asm volatile("" ::: "memory"); } while (0)

constexpr size_t MiB = 1u << 20;
constexpr size_t WS_CTL = 0, CTL_ZERO_BYTES = 1 * MiB;
constexpr size_t WS_WNF  = 1 * MiB;
constexpr size_t WS_WD   = WS_WNF + 56 * MiB;
constexpr size_t WS_WAO  = WS_WD + 23 * MiB;
constexpr size_t WS_WGO  = WS_WAO + 2 * MiB;
constexpr size_t WS_WP   = WS_WGO + 2 * MiB;
constexpr size_t WS_WADA = WS_WP + 1 * MiB;
constexpr size_t WS_SC   = WS_WADA + 48 * MiB;
constexpr size_t WS_SH   = WS_SC + 1 * MiB;
constexpr size_t WS_MOD  = WS_SH + 3 * MiB;
constexpr size_t WS_CB   = WS_MOD + 13 * MiB;
constexpr size_t WS_AN   = WS_CB + 28 * MiB;
constexpr size_t WS_DP   = WS_AN + 33 * MiB;
constexpr size_t WS_ACT  = WS_DP + 33 * MiB;
constexpr size_t WS_HG   = WS_ACT + 91 * MiB;
constexpr size_t WS_HU   = WS_HG + 6 * MiB;
constexpr size_t WS_TG   = WS_HU + 6 * MiB;
constexpr size_t WS_RSS  = WS_TG + 6 * MiB;
constexpr size_t WS_QB   = WS_RSS + 2 * MiB;
constexpr size_t WS_KB   = WS_QB + 25 * MiB;
constexpr size_t WS_VB   = WS_KB + 25 * MiB;
constexpr size_t WS_AO   = WS_VB + 25 * MiB;
constexpr size_t WS_LSE  = WS_AO + 25 * MiB;
constexpr size_t WS_GQ   = WS_LSE + 1 * MiB;
constexpr size_t WS_GK   = WS_GQ + 17 * MiB;
constexpr size_t WS_QD   = WS_GK + 17 * MiB;
constexpr size_t WS_KET  = WS_QD + 17 * MiB;
constexpr size_t WS_ATT  = WS_KET + 16 * MiB;
constexpr size_t WS_DEC  = WS_ATT + 8 * MiB;
constexpr size_t WS_GV   = WS_DEC + 1 * MiB;
constexpr size_t WS_GR   = WS_GV + 33 * MiB;
constexpr size_t WS_GD   = WS_GR + 33 * MiB;
constexpr size_t WS_GO   = WS_GD + 2 * MiB;
constexpr size_t WS_GA   = WS_GO + 66 * MiB;
constexpr size_t WS_DUMMY = WS_GA + 33 * MiB;
constexpr size_t WS_DUMMY2 = WS_DUMMY + 66 * MiB;
constexpr size_t WS_DUMMY3 = WS_DUMMY2 + 33 * MiB;
constexpr size_t WS_END  = WS_DUMMY3 + 2 * MiB;
constexpr int CW_BAR = 4096;
constexpr int CW_FINCNT = 16384;

constexpr size_t O_Y     = 0;
constexpr size_t O_POOLP = O_Y + (size_t)M * D;
constexpr size_t O_POOLS = O_POOLP + (size_t)2 * 8 * 15 * D;
constexpr size_t O_W1P   = O_POOLS + (size_t)2 * 128 * 15 * D;
constexpr size_t O_W1S   = O_W1P + (size_t)8 * 128 * 512;
constexpr size_t O_W2P   = O_W1S + (size_t)128 * 128 * 512;
constexpr size_t O_W2S   = O_W2P + (size_t)8 * 512 * 512;
constexpr size_t O_W3P   = O_W2S + (size_t)128 * 512 * 512;
constexpr size_t O_W3S   = O_W3P + (size_t)8 * 2048 * 512;
constexpr size_t O_GLAP  = O_W3S + (size_t)128 * 2048 * 512;
constexpr size_t O_GLAS  = O_GLAP + (size_t)8 * 4 * 128 * 256;
constexpr size_t O_CONVP = O_GLAS + (size_t)128 * 4 * 128 * 256;
constexpr size_t O_CONVS = O_CONVP + (size_t)4 * 8 * 2 * DFF;
constexpr size_t O_END   = O_CONVS + (size_t)4 * 128 * 2 * DFF;

namespace pg8 {
#define PG8_LAS __attribute__((address_space(3)))
typedef unsigned short bf16_t;
typedef short bf16x8 __attribute__((ext_vector_type(8)));
typedef float f32x4 __attribute__((ext_vector_type(4)));
typedef unsigned u32x4 __attribute__((ext_vector_type(4)));
constexpr int BM = 256, BK = 64, HALF = 128, HTB = HALF * BK * 2  , STAGE_BYTES = 8 * HTB, NXCD = 8, WGM = 8;

__host__ __device__ __forceinline__ int lds_byte(int r, int c) { const int st = (r >> 4) * 2 + (c >> 5), rr = r & 15, cc = c & 31, ob = rr * 64 + cc * 2; return st * 1024 + (ob ^ (((ob >> 9) & 1) << 5)); }
__host__ __device__ __forceinline__ void stage_rc(int b, int& R, int& C) { const int st = b / 1024, sb = b % 1024, swz = sb ^ (((sb >> 9) & 1) << 5); R = (st >> 1) * 16 + swz / 64; C = (st & 1) * 32 + (swz % 64) / 2; }
__host__ __device__ __forceinline__ int perm32(int rho) { const int n = rho >> 4, i = rho & 15; return 8 * (i >> 2) + 4 * n + (i & 3); }

struct Unit { int pm, pn; };
struct Gemm { const bf16_t* A; const bf16_t* Bt; int lda, ldb, K, a_pn; };

struct StaticOrder {
    int nM, nN, nwg, G, c;
    __host__ __device__ __forceinline__ void init(int M_, int N_, int G_, int c_) { nM = M_ / BM; nN = N_ / BM; nwg = nM * nN; G = G_; c = c_; }
    __host__ __device__ __forceinline__ bool next(int i, Unit& u) const {
        const long L = (long)i * G + c; if (L >= nwg) return false;
        int wgid = (int)L; { const int q = nwg / NXCD, r = nwg % NXCD, xcd = wgid % NXCD, off = wgid / NXCD; wgid = (xcd < r ? xcd * (q + 1) : r * (q + 1) + (xcd - r) * q) + off; }
        const int nig = WGM * nN, gid = wgid / nig, fm = gid * WGM, gsz = (nM - fm) < WGM ? (nM - fm) : WGM;
        u.pm = fm + ((wgid % nig) % gsz); u.pn = (wgid % nig) / gsz; return true;
    }
    __device__ __forceinline__ void a_ready(const Unit&) const {}
    __device__ __forceinline__ void done(const Unit&) const {}
};

template <class Epi, class Sched, bool ALIGN_EPI = false, bool SP2 = false>
__device__ __forceinline__ void gemm_phase(PG8_LAS unsigned char* lds, const Gemm g, const Sched& S, const Epi& E, int wave_id  ) {
    const int lane = fresh_lane(), wid = wave_id, tid = wid * 64 + lane, wr = wid >> 2, wc = wid & 3, fr = lane & 15, fq = lane >> 4;
    const int K = g.K, nt = K / BK;
    unsigned voffA[2], voffB[2];
#pragma unroll
    for (int i = 0; i < 2; ++i) { int R, C; stage_rc(tid * 16 + i * 8192, R, C); const int Rb = Epi::PERM ? ((R & ~31) + perm32(R & 31)) : R;
        voffA[i] = (unsigned)(R * g.lda + C) * 2u; voffB[i] = (unsigned)(Rb * g.ldb + C) * 2u; }
    const size_t kstep = (size_t)(BK * 2);
    const size_t hstepA = (size_t)HALF * g.lda * 2, hstepB = (size_t)HALF * g.ldb * 2;
    const size_t tstepA = 2 * hstepA, tstepB = 2 * hstepB, pnA = (size_t)g.a_pn * 2;
    const unsigned ldsw = (unsigned)wid * 1024u;
    const int aoff = lds_byte(wr * 64 + fr, fq * 8), boff = lds_byte(wc * 32 + fr, fq * 8);
#define PG8_SA(b, h) (((b) * 2 + (h)) * HTB)
#define PG8_SB(b, h) ((4 + (b) * 2 + (h)) * HTB)
#define PG8_STAGE(bufoff, gbase, voff) do { _Pragma("unroll") for (int _i = 0; _i < 2; ++_i) \
        __builtin_amdgcn_global_load_lds((const unsigned*)((const char*)(gbase) + (voff)[_i]), (PG8_LAS unsigned*)(lds + (bufoff) + ldsw + _i * 8192), 16, 0, 0); } while (0)
#define PG8_LDA(dst, b, h) do { _Pragma("unroll") for (int m = 0; m < 4; ++m) _Pragma("unroll") for (int k = 0; k < 2; ++k) dst[m][k] = *(const PG8_LAS bf16x8*)(lds + PG8_SA(b, h) + aoff + m * 2048 + k * 1024); } while (0)
#define PG8_LDB(dst, b, h) do { _Pragma("unroll") for (int n = 0; n < 2; ++n) _Pragma("unroll") for (int k = 0; k < 2; ++k) dst[n][k] = *(const PG8_LAS bf16x8*)(lds + PG8_SB(b, h) + boff + n * 2048 + k * 1024); } while (0)
#define PG8_MMA(ai, bj, At, Bt) do { __builtin_amdgcn_s_setprio(1); _Pragma("unroll") for (int m = 0; m < 4; ++m) _Pragma("unroll") for (int n = 0; n < 2; ++n) _Pragma("unroll") for (int k = 0; k < 2; ++k) \
        acc[ai][bj][m][n] = __builtin_amdgcn_mfma_f32_16x16x32_bf16(Bt[n][k], At[m][k], acc[ai][bj][m][n], 0, 0, 0); __builtin_amdgcn_s_setprio(0); } while (0)
#define PG8_WAIT_V(n) asm volatile("s_waitcnt vmcnt(" #n ")" ::: "memory")
#define PG8_WAIT_L(n) asm volatile("s_waitcnt lgkmcnt(" #n ")" ::: "memory")
#define PG8_BAR __builtin_amdgcn_s_barrier()
#define PG8_SCHED __builtin_amdgcn_sched_barrier(0)
    Unit cur, nxt; int ui = 0;
    if (!S.next(0, cur)) return;
    f32x4 acc[2][2][4][2];
#pragma unroll
    for (int a = 0; a < 2; ++a)
#pragma unroll
        for (int b = 0; b < 2; ++b)
#pragma unroll
            for (int m = 0; m < 4; ++m)
#pragma unroll
                for (int n = 0; n < 2; ++n) acc[a][b][m][n] = (f32x4){0.f, 0.f, 0.f, 0.f};
    bf16x8 At[4][2], B0[2][2], B1[2][2];
    const char* cA = (const char*)g.A + (size_t)cur.pm * tstepA + (size_t)cur.pn * pnA; const char* cB = (const char*)g.Bt + (size_t)cur.pn * tstepB;
    S.a_ready(cur);
    if constexpr (SP2) {
        PG8_STAGE(PG8_SB(0, 0), cB, voffB); PG8_STAGE(PG8_SB(0, 1), cB + hstepB, voffB); PG8_STAGE(PG8_SA(0, 0), cA, voffA); PG8_STAGE(PG8_SA(0, 1), cA + hstepA, voffA);
        if (wr == 1) PG8_BAR;
        PG8_WAIT_V(2); PG8_BAR;
        PG8_STAGE(PG8_SB(1, 0), cB + kstep, voffB); PG8_STAGE(PG8_SA(1, 0), cA + kstep, voffA); PG8_STAGE(PG8_SB(1, 1), cB + hstepB + kstep, voffB);
        PG8_WAIT_V(6); PG8_BAR;
    } else {
        PG8_STAGE(PG8_SB(0, 0), cB, voffB); PG8_STAGE(PG8_SA(0, 0), cA, voffA); PG8_STAGE(PG8_SB(0, 1), cB + hstepB, voffB); PG8_STAGE(PG8_SA(0, 1), cA + hstepA, voffA);
        if (wr == 1) PG8_BAR;
        PG8_WAIT_V(4); PG8_BAR;
        PG8_STAGE(PG8_SB(1, 0), cB + kstep, voffB); PG8_STAGE(PG8_SA(1, 0), cA + kstep, voffA); PG8_STAGE(PG8_SB(1, 1), cB + hstepB + kstep, voffB);
        PG8_WAIT_V(6); PG8_BAR;
    }
    for (;;) {
        const bool has_next = S.next(ui + 1, nxt);
        const char* nA = has_next ? (const char*)g.A + (size_t)nxt.pm * tstepA + (size_t)nxt.pn * pnA : cA; const char* nB = has_next ? (const char*)g.Bt + (size_t)nxt.pn * tstepB : cB;
        for (int t = 0; t < nt; t += 2) {
            const bool last = (t == nt - 2);
            const char* a1 = cA + (size_t)(t + 1) * kstep;
            const char* a2 = last ? nA : cA + (size_t)(t + 2) * kstep; const char* b2 = last ? nB : cB + (size_t)(t + 2) * kstep;
            const char* a3 = a2 + kstep; const char* b3 = b2 + kstep;
            if (last && has_next) S.a_ready(nxt);
            if constexpr (SP2) {
            PG8_LDB(B0, 0, 0); PG8_LDB(B1, 0, 1); PG8_SCHED; PG8_LDA(At, 0, 0); PG8_STAGE(PG8_SA(1, 1), a1 + hstepA, voffA);
            PG8_WAIT_V(8); PG8_WAIT_L(0); PG8_BAR; PG8_MMA(0, 0, At, B0); PG8_MMA(0, 1, At, B1); PG8_BAR; PG8_SCHED;
            PG8_LDA(At, 0, 1); PG8_STAGE(PG8_SB(0, 0), b2, voffB); PG8_STAGE(PG8_SB(0, 1), b2 + hstepB, voffB); PG8_STAGE(PG8_SA(0, 0), a2, voffA);
            PG8_WAIT_V(8); PG8_WAIT_L(0); PG8_BAR; PG8_MMA(1, 0, At, B0); PG8_MMA(1, 1, At, B1); PG8_BAR; PG8_SCHED;
            PG8_LDB(B0, 1, 0); PG8_LDB(B1, 1, 1); PG8_SCHED; PG8_LDA(At, 1, 0); PG8_STAGE(PG8_SA(0, 1), a2 + hstepA, voffA);
            PG8_WAIT_V(8); PG8_WAIT_L(0); PG8_BAR; PG8_MMA(0, 0, At, B0); PG8_MMA(0, 1, At, B1); PG8_BAR; PG8_SCHED;
            PG8_LDA(At, 1, 1); PG8_STAGE(PG8_SB(1, 0), b3, voffB); PG8_STAGE(PG8_SB(1, 1), b3 + hstepB, voffB); PG8_STAGE(PG8_SA(1, 0), a3, voffA);
            PG8_WAIT_V(8); PG8_WAIT_L(0); PG8_BAR; PG8_MMA(1, 0, At, B0); PG8_MMA(1, 1, At, B1); PG8_BAR; PG8_SCHED;
            } else {
            PG8_LDB(B0, 0, 0); PG8_SCHED; PG8_LDA(At, 0, 0); PG8_STAGE(PG8_SA(1, 1), a1 + hstepA, voffA);
            PG8_WAIT_L(8); PG8_BAR; PG8_WAIT_L(0); PG8_MMA(0, 0, At, B0); PG8_BAR; PG8_SCHED;
            PG8_LDB(B1, 0, 1); PG8_STAGE(PG8_SB(0, 0), b2, voffB);
            PG8_BAR; PG8_WAIT_L(0); PG8_MMA(0, 1, At, B1); PG8_BAR;
            PG8_LDA(At, 0, 1); PG8_STAGE(PG8_SA(0, 0), a2, voffA);
            PG8_BAR; PG8_WAIT_L(0); PG8_MMA(1, 0, At, B0); PG8_BAR; PG8_SCHED;
            PG8_STAGE(PG8_SB(0, 1), b2 + hstepB, voffB);
            PG8_WAIT_V(6); PG8_BAR; PG8_MMA(1, 1, At, B1); PG8_BAR;
            PG8_LDB(B0, 1, 0); PG8_SCHED; PG8_LDA(At, 1, 0); PG8_STAGE(PG8_SA(0, 1), a2 + hstepA, voffA);
            PG8_WAIT_L(8); PG8_BAR; PG8_WAIT_L(0); PG8_MMA(0, 0, At, B0); PG8_BAR; PG8_SCHED;
            PG8_LDB(B1, 1, 1); PG8_STAGE(PG8_SB(1, 0), b3, voffB);
            PG8_BAR; PG8_WAIT_L(0); PG8_MMA(0, 1, At, B1); PG8_BAR;
            PG8_LDA(At, 1, 1); PG8_STAGE(PG8_SA(1, 0), a3, voffA);
            PG8_BAR; PG8_WAIT_L(0); PG8_MMA(1, 0, At, B0); PG8_BAR; PG8_SCHED;
            PG8_STAGE(PG8_SB(1, 1), b3 + hstepB, voffB);
            PG8_WAIT_V(6); PG8_BAR; PG8_MMA(1, 1, At, B1); PG8_BAR;
            }
        }
        if constexpr (ALIGN_EPI) { if (wr == 0) PG8_BAR; }
        if constexpr (!Epi::AFTER_DRAIN) { E(acc, cur, wr, wc, fr, fq); S.done(cur); }
        if (!has_next) break;
#pragma unroll
        for (int a = 0; a < 2; ++a)
#pragma unroll
            for (int b = 0; b < 2; ++b)
#pragma unroll
                for (int m = 0; m < 4; ++m)
#pragma unroll
                    for (int n = 0; n < 2; ++n) acc[a][b][m][n] = (f32x4){0.f, 0.f, 0.f, 0.f};
        cur = nxt; cA = nA; cB = nB; ++ui;
        if constexpr (ALIGN_EPI) { if (wr == 1) PG8_BAR; }
    }
    PG8_WAIT_V(0);
    if constexpr (!ALIGN_EPI) { if (wr == 0) PG8_BAR; }
    PG8_BAR;
    if constexpr (Epi::AFTER_DRAIN) { E.fused(acc, cur, wr, wc, fr, fq, lds, wid, lane); S.done(cur); }
#undef PG8_SA
#undef PG8_SB
#undef PG8_STAGE
#undef PG8_LDA
#undef PG8_LDB
#undef PG8_MMA
#undef PG8_WAIT_V
#undef PG8_WAIT_L
#undef PG8_BAR
#undef PG8_SCHED
}

typedef float f32x2 __attribute__((ext_vector_type(2)));
typedef __bf16 hb2 __attribute__((ext_vector_type(2)));
typedef unsigned u32x2 __attribute__((ext_vector_type(2)));
__device__ __forceinline__ unsigned cvt_pk_bf16(float lo, float hi) { f32x2 v = {lo, hi}; return __builtin_bit_cast(unsigned, __builtin_convertvector(v, hb2)); }
__device__ __forceinline__ f32x2 gelu_pk(f32x2 v) {
    const f32x2 av = __builtin_elementwise_abs(v), d = av * 0.2316418882f + 1.0f;
    f32x2 t; t.x = __builtin_amdgcn_rcpf(d.x); t.y = __builtin_amdgcn_rcpf(d.y);
    f32x2 q = t * 0.5307027145f + (-0.7265760135f); q = q * t + 0.7107068705f; q = q * t + (-0.142248368f); q = q * t + 0.127414796f; q = q * t;
    const f32x2 s = (v * v) * (-0.72134752044f);
    f32x2 e; e.x = __builtin_amdgcn_exp2f(s.x); e.y = __builtin_amdgcn_exp2f(s.y);
    const f32x2 m = v * (q * e), r = v - m;
    f32x2 o; o.x = v.x < 0.f ? m.x : r.x; o.y = v.y < 0.f ? m.y : r.y; return o;
}
__device__ __forceinline__ float gelu1(float v) { f32x2 r = gelu_pk((f32x2){v, v}); return r.x; }
constexpr int E_MP = 16384, E_DFF = 2816, E_MODLD = 24576;
__device__ __forceinline__ float row_rinv(const float* rss, int row) { return __builtin_amdgcn_rsqf(rss[row] * (1.0f / 1024.0f) + 1e-6f); }
__device__ __forceinline__ float dpp_ror1(float v) { return __builtin_bit_cast(float, __builtin_amdgcn_update_dpp(0, __builtin_bit_cast(int, v), 0x121, 0xf, 0xf, false)); }
__device__ __forceinline__ float dpp_ror2(float v) { return __builtin_bit_cast(float, __builtin_amdgcn_update_dpp(0, __builtin_bit_cast(int, v), 0x122, 0xf, 0xf, false)); }
__device__ __forceinline__ void ld8(const float* p, float (&v)[8]) { const f32x4 a = *(const f32x4*)p, b = *(const f32x4*)(p + 4); v[0] = a[0]; v[1] = a[1]; v[2] = a[2]; v[3] = a[3]; v[4] = b[0]; v[5] = b[1]; v[6] = b[2]; v[7] = b[3]; }
__device__ __forceinline__ void st8(float* p, const float (&v)[8]) { *(f32x4*)p = (f32x4){v[0], v[1], v[2], v[3]}; *(f32x4*)(p + 4) = (f32x4){v[4], v[5], v[6], v[7]}; }
__device__ __forceinline__ void st8bf(bf16_t* p, const float (&v)[8]) { u32x4 w; w.x = cvt_pk_bf16(v[0], v[1]); w.y = cvt_pk_bf16(v[2], v[3]); w.z = cvt_pk_bf16(v[4], v[5]); w.w = cvt_pk_bf16(v[6], v[7]); *(u32x4*)p = w; }

struct EpiRide {
    const float* cache3; float* out3; int sbase, nunits;
    template <int NPT> __device__ __forceinline__ void load(int L, int tid, f32x4 (&v)[NPT], const f32x4*& src, f32x4*& dst, unsigned& e0, unsigned& n) const {
        constexpr int PPS = 32 / NPT;
        const unsigned sl = (unsigned)(sbase + L / PPS), b = sl >> 4, k = sl & 15u;
        src = (const f32x4*)cache3 + (size_t)b * (2048 * 128) + 512 + (size_t)k * 16384; dst = (f32x4*)out3 + (size_t)b * (2048 * 128) + (size_t)k * 16384;
        n = 261632u - k * 16384u < 16384u ? 261632u - k * 16384u : 16384u; e0 = (unsigned)((L % PPS) * NPT * 512 + tid);
#pragma unroll
        for (int u = 0; u < NPT; ++u) { const unsigned e = e0 + (unsigned)(u * 512); v[u] = __builtin_nontemporal_load(src + (e < n ? e : n - 1u)); }
    }
    template <int NPT> __device__ __forceinline__ void store(const f32x4 (&v)[NPT], f32x4* dst, unsigned e0, unsigned n) const {
#pragma unroll
        for (int u = 0; u < NPT; ++u) { const unsigned e = e0 + (unsigned)(u * 512); if (e < n) __builtin_nontemporal_store(v[u], dst + e); }
    }
};
struct EpiMod {
    static constexpr bool PERM = true, AFTER_DRAIN = false;
    float* mod; const float* b_ada; bf16_t* sh;
    __device__ __forceinline__ void operator()(const f32x4 (&acc)[2][2][4][2], const Unit& u, int wr, int wc, int fr, int fq) const {
        const int l = u.pn / 24, rem = u.pn % 24, mi = rem >> 2, cbk = rem & 3;
        const int variant = (mi == 3) ? l : ((mi == 0 && l == 1) ? 4 : ((mi == 0 && l == 2) ? 5 : -1));
#pragma unroll
        for (int bj = 0; bj < 2; ++bj) {
            const int col0 = u.pn * 256 + bj * 128 + wc * 32 + 8 * fq;
            float bv[8]; ld8(b_ada + col0, bv);
#pragma unroll
            for (int ai = 0; ai < 2; ++ai)
#pragma unroll
                for (int m = 0; m < 4; ++m) {
                    const int row = ai * 128 + wr * 64 + m * 16 + fr;
                    float v[8];
#pragma unroll
                    for (int j = 0; j < 4; ++j) { v[j] = acc[ai][bj][m][0][j] + bv[j]; v[4 + j] = acc[ai][bj][m][1][j] + bv[4 + j]; }
                    if (row < 136) st8(mod + (size_t)row * E_MODLD + col0, v);
                    if (variant >= 0) st8bf(sh + ((size_t)(variant * 256 + row)) * 1024 + cbk * 256 + bj * 128 + wc * 32 + 8 * fq, v);
                }
        }
    }
};
struct EpiCb {
    static constexpr bool PERM = true, AFTER_DRAIN = false;
    float* cb;
    __device__ __forceinline__ void operator()(const f32x4 (&acc)[2][2][4][2], const Unit& u, int wr, int wc, int fr, int fq) const {
        const int v = u.pm; const int nv = v < 4 ? 5632 : (v == 4 ? 2304 : 3328); const int toff = v < 4 ? 22 * v : (v == 4 ? 88 : 97);
        const size_t base = v < 4 ? (size_t)v * 256 * 5632 : (v == 4 ? (size_t)4 * 256 * 5632 : (size_t)4 * 256 * 5632 + (size_t)256 * 2304);
#pragma unroll
        for (int bj = 0; bj < 2; ++bj) {
            const int col0 = (u.pn - toff) * 256 + bj * 128 + wc * 32 + 8 * fq;
#pragma unroll
            for (int ai = 0; ai < 2; ++ai)
#pragma unroll
                for (int m = 0; m < 4; ++m) {
                    const int row = ai * 128 + wr * 64 + m * 16 + fr;
                    float vv[8];
#pragma unroll
                    for (int j = 0; j < 4; ++j) { vv[j] = acc[ai][bj][m][0][j]; vv[4 + j] = acc[ai][bj][m][1][j]; }
                    st8(cb + base + (size_t)row * nv + col0, vv);
                }
        }
    }
};
struct EpiRes {
    static constexpr bool PERM = true, AFTER_DRAIN = false;
    const float* xin_p; const float* xin_s;
    float* xout;
    const float* gate;
    const float* pscale;
    const float* ngain; const float* nscale;
    bf16_t* an; float* rss;
    const float* fgain; unsigned* pcnt;
    __device__ __forceinline__ void operator()(const f32x4 (&acc)[2][2][4][2], const Unit& u, int wr, int wc, int fr, int fq) const {
        const int bi = u.pm >> 3;
        float gt[2][8], gn[2][8];
#pragma unroll
        for (int bj = 0; bj < 2; ++bj) {
            const int col0 = u.pn * 256 + bj * 128 + wc * 32 + 8 * fq;
            ld8(gate + (size_t)bi * E_MODLD + col0, gt[bj]);
            if (pscale) { float ps[8]; ld8(pscale + col0, ps);
#pragma unroll
                for (int j = 0; j < 8; ++j) gt[bj][j] *= ps[j]; }
            if (ngain) { float ns[8]; ld8(ngain + col0, gn[bj]); ld8(nscale + (size_t)bi * E_MODLD + col0, ns);
#pragma unroll
                for (int j = 0; j < 8; ++j) gn[bj][j] *= (1.0f + ns[j]); }
        }
#pragma unroll
        for (int ai = 0; ai < 2; ++ai)
#pragma unroll
            for (int m = 0; m < 4; ++m) {
                const int row = u.pm * 256 + ai * 128 + wr * 64 + m * 16 + fr;
                float ss = 0.f;
#pragma unroll
                for (int bj = 0; bj < 2; ++bj) {
                    const int col0 = u.pn * 256 + bj * 128 + wc * 32 + 8 * fq;
                    float xo[8], xn[8];
                    ld8(xin_p + (size_t)row * 1024 + col0, xo);
#pragma unroll
                    for (int j = 0; j < 4; ++j) { xn[j] = xo[j] + gt[bj][j] * acc[ai][bj][m][0][j]; xn[4 + j] = xo[4 + j] + gt[bj][4 + j] * acc[ai][bj][m][1][j]; }
                    if (fgain) st8(xout + (size_t)row * 1024 + col0, xn);
                    else { __builtin_nontemporal_store((f32x4){xn[0], xn[1], xn[2], xn[3]}, (f32x4*)(xout + (size_t)row * 1024 + col0)); __builtin_nontemporal_store((f32x4){xn[4], xn[5], xn[6], xn[7]}, (f32x4*)(xout + (size_t)row * 1024 + col0 + 4)); }
#pragma unroll
                    for (int j = 0; j < 8; ++j) ss += xn[j] * xn[j];
                    if (ngain) { float o[8];
#pragma unroll
                        for (int j = 0; j < 8; ++j) o[j] = xn[j] * gn[bj][j];
                        st8bf(an + (size_t)row * 1024 + col0, o); }
                }
                ss += __shfl_xor(ss, 16); ss += __shfl_xor(ss, 32);
                if (fq == 0) atomicAdd(rss + row, ss);
                if (m & 1) asm volatile("" ::: "memory");
            }
        if (fgain) {
            asm volatile("s_waitcnt vmcnt(0)" ::: "memory");
            unsigned* cw = pcnt + 64 * u.pm;
            if (fr == 0 && fq == 0) __hip_atomic_fetch_add(cw, 1u, __ATOMIC_RELAXED, __HIP_MEMORY_SCOPE_AGENT);
            { unsigned sp = 0; while (__hip_atomic_load(cw, __ATOMIC_RELAXED, __HIP_MEMORY_SCOPE_AGENT) < 32u) { __builtin_amdgcn_s_sleep(1); if (++sp > (1u << 20)) break; } }
            __builtin_amdgcn_fence(__ATOMIC_ACQUIRE, "agent");
            asm volatile("s_waitcnt vmcnt(0)" ::: "memory");
            float fg[2][8];
#pragma unroll
            for (int bj = 0; bj < 2; ++bj) ld8(fgain + u.pn * 256 + bj * 128 + wc * 32 + 8 * fq, fg[bj]);
#pragma unroll
            for (int ai = 0; ai < 2; ++ai)
#pragma unroll
                for (int m = 0; m < 4; ++m) {
                    const int row = u.pm * 256 + ai * 128 + wr * 64 + m * 16 + fr;
                    const float rinv = __builtin_amdgcn_rsqf(__hip_atomic_load(rss + row, __ATOMIC_RELAXED, __HIP_MEMORY_SCOPE_AGENT) * (1.0f / 1024.0f) + 1e-6f);
#pragma unroll
                    for (int bj = 0; bj < 2; ++bj) {
                        const int col0 = u.pn * 256 + bj * 128 + wc * 32 + 8 * fq;
                        float xn[8]; ld8(xout + (size_t)row * 1024 + col0, xn);
#pragma unroll
                        for (int j = 0; j < 8; ++j) xn[j] = xn[j] * rinv * fg[bj][j];
                        st8(xout + (size_t)row * 1024 + col0, xn);
                    }
                    if (m & 1) asm volatile("" ::: "memory");
                }
        }
    }
};
struct EpiFfnIn {
    static constexpr bool PERM = true, AFTER_DRAIN = false;
    const float* rss; const float* cb;
    const float* cw; const float* cbv;
    const float* cstate;
    bf16_t* act;
    float* hg; float* hu; float* tg;
    float* conv_p; float* conv_s;
    EpiRide ride;
    __device__ __forceinline__ void operator()(const f32x4 (&acc)[2][2][4][2], const Unit& u, int wr, int wc, int fr, int fq) const {
        const bool prompt = u.pm < 64;
        const int rL = u.pm * 22 + u.pn; const bool rdo = rL < ride.nunits; f32x4 rv_[1]; const f32x4* rs_ = nullptr; f32x4* rd_ = nullptr; unsigned re_ = 0u, rn_ = 0u;
        if (rdo) ride.load<1>(rL, (wr * 4 + wc) * 64 + fq * 16 + fr, rv_, rs_, rd_, re_, rn_);
        float rv[2][4];
#pragma unroll
        for (int ai = 0; ai < 2; ++ai)
#pragma unroll
            for (int m = 0; m < 4; ++m) rv[ai][m] = row_rinv(rss, u.pm * 256 + ai * 128 + wr * 64 + m * 16 + fr);
#pragma unroll
        for (int n = 0; n < 2; ++n) {
            const int gc0 = u.pn * 128 + wc * 32 + 8 * fq + 4 * n;
            const int cc0 = u.pn * 256 + wc * 32 + 8 * fq + 4 * n;
            const f32x4 w0 = *(const f32x4*)(cw + gc0), w1 = *(const f32x4*)(cw + E_DFF + gc0), w2 = *(const f32x4*)(cw + 2 * E_DFF + gc0), bb = *(const f32x4*)(cbv + gc0);
            if (prompt) {
                const int bi = u.pm >> 3;
                const f32x4 cg = *(const f32x4*)(cb + (size_t)bi * 5632 + cc0), cu = *(const f32x4*)(cb + (size_t)bi * 5632 + cc0 + 128);
#pragma unroll
                for (int ai = 0; ai < 2; ++ai) {
                    f32x4 gp = {0.f, 0.f, 0.f, 0.f};
#pragma unroll
                    for (int m = 0; m < 4; ++m) {
                        const int row = u.pm * 256 + ai * 128 + wr * 64 + m * 16 + fr;
                        const float rinv = rv[ai][m];
                        const f32x4 g = acc[ai][0][m][n] * rinv + cg, uu = acc[ai][1][m][n] * rinv + cu;
                        f32x4 a;
#pragma unroll
                        for (int j = 0; j < 4; ++j) {
                            const float r1c = dpp_ror1(g[j]), r2c = dpp_ror2(g[j]), r1p = dpp_ror1(gp[j]), r2p = dpp_ror2(gp[j]);
                            const float gm1 = fr >= 1 ? r1c : r1p, gm2 = fr >= 2 ? r2c : r2p;
                            a[j] = w0[j] * gm2 + w1[j] * gm1 + w2[j] * g[j] + bb[j];
                        }
                        const f32x2 e0 = gelu_pk((f32x2){a[0], a[1]}), e1 = gelu_pk((f32x2){a[2], a[3]});
                        const int strip = row >> 6;
                        if (m > 0 || fr >= 2) { u32x2 w; w.x = cvt_pk_bf16(e0.x * uu[0], e0.y * uu[1]); w.y = cvt_pk_bf16(e1.x * uu[2], e1.y * uu[3]); *(u32x2*)(act + (size_t)row * E_DFF + gc0) = w; }
                        if (m == 0 && fr < 2) { *(f32x4*)(hg + ((size_t)strip * 2 + fr) * E_DFF + gc0) = g; *(f32x4*)(hu + ((size_t)strip * 2 + fr) * E_DFF + gc0) = uu; }
                        if (m == 3 && fr >= 14) { *(f32x4*)(tg + ((size_t)strip * 2 + (fr - 14)) * E_DFF + gc0) = g;
                            if ((strip & 31) == 31) *(f32x4*)(conv_p + ((size_t)bi * 2 + (fr - 14)) * E_DFF + gc0) = g; }
                        gp = g;
                        asm volatile("" ::: "memory");
                    }
                }
            } else {
#pragma unroll
                for (int ai = 0; ai < 2; ++ai)
#pragma unroll
                    for (int m = 0; m < 4; ++m) {
                        const int row = u.pm * 256 + ai * 128 + wr * 64 + m * 16 + fr;
                        const int rs = row - E_MP, b = rs >> 2, t = rs & 3, bi = 8 + b;
                        const float rinv = rv[ai][m];
                        const f32x4 cg = *(const f32x4*)(cb + (size_t)bi * 5632 + cc0), cu = *(const f32x4*)(cb + (size_t)bi * 5632 + cc0 + 128);
                        const f32x4 s0 = *(const f32x4*)(cstate + ((size_t)b * 2 + 0) * E_DFF + gc0), s1 = *(const f32x4*)(cstate + ((size_t)b * 2 + 1) * E_DFF + gc0);
                        const f32x4 g = acc[ai][0][m][n] * rinv + cg, uu = acc[ai][1][m][n] * rinv + cu;
                        f32x4 a;
#pragma unroll
                        for (int j = 0; j < 4; ++j) {
                            const float r1c = dpp_ror1(g[j]), r2c = dpp_ror2(g[j]);
                            const float gm1 = t >= 1 ? r1c : s1[j], gm2 = t >= 2 ? r2c : (t == 1 ? s1[j] : s0[j]);
                            a[j] = w0[j] * gm2 + w1[j] * gm1 + w2[j] * g[j] + bb[j];
                        }
                        const f32x2 e0 = gelu_pk((f32x2){a[0], a[1]}), e1 = gelu_pk((f32x2){a[2], a[3]});
                        { u32x2 w; w.x = cvt_pk_bf16(e0.x * uu[0], e0.y * uu[1]); w.y = cvt_pk_bf16(e1.x * uu[2], e1.y * uu[3]); *(u32x2*)(act + (size_t)row * E_DFF + gc0) = w; }
                        if (t >= 2) *(f32x4*)(conv_s + ((size_t)b * 2 + (t - 2)) * E_DFF + gc0) = g;
                        asm volatile("" ::: "memory");
                    }
            }
        }
        if (rdo) ride.store<1>(rv_, rd_, re_, rn_);
    }
};
struct EpiQkv {
    static constexpr bool PERM = true, AFTER_DRAIN = false;
    const float* rss; const float* cb;
    bf16_t* qkv;
    float* out;
    EpiRide ride;
    __device__ __forceinline__ void operator()(const f32x4 (&acc)[2][2][4][2], const Unit& u, int wr, int wc, int fr, int fq) const {
        const int rL = u.pm * 9 + u.pn; const bool rdo = rL < ride.nunits; f32x4 rv_[4]; const f32x4* rs_ = nullptr; f32x4* rd_ = nullptr; unsigned re_ = 0u, rn_ = 0u;
        if (rdo) ride.load<4>(rL, (wr * 4 + wc) * 64 + fq * 16 + fr, rv_, rs_, rd_, re_, rn_);
        const int sec = u.pn / 3, g = u.pn % 3, W = 128 << (2 * g);
        bf16_t* dst = qkv + (size_t)sec * ((WS_KB - WS_QB) / 2);
        const size_t offp = g == 0 ? O_W1P : (g == 1 ? O_W2P : O_W3P), offs = g == 0 ? O_W1S : (g == 1 ? O_W2S : O_W3S);
        float* wp = out + offp; float* ws = out + offs;
        const float sc = sec == 0 ? 0.125f : 1.0f;
        const bool prompt = u.pm < 64;
        float rv[2][4], cbv[2][8];
#pragma unroll
        for (int ai = 0; ai < 2; ++ai)
#pragma unroll
            for (int m = 0; m < 4; ++m) rv[ai][m] = row_rinv(rss, u.pm * 256 + ai * 128 + wr * 64 + m * 16 + fr) * sc;
#pragma unroll
        for (int bj = 0; bj < 2; ++bj) ld8(cb + (size_t)(prompt ? (u.pm >> 3) : 0) * 2304 + u.pn * 256 + bj * 128 + wc * 32 + 8 * fq, cbv[bj]);
#pragma unroll
        for (int ai = 0; ai < 2; ++ai)
#pragma unroll
            for (int m = 0; m < 4; ++m) {
                const int row = u.pm * 256 + ai * 128 + wr * 64 + m * 16 + fr;
                const int bi = prompt ? (u.pm >> 3) : 8 + ((row - E_MP) >> 2);
                const float rinv = rv[ai][m];
#pragma unroll
                for (int bj = 0; bj < 2; ++bj) {
                    const int lc = bj * 128 + wc * 32 + 8 * fq;
                    float c8[8], v[8]; if (prompt) {
#pragma unroll
                        for (int j = 0; j < 8; ++j) c8[j] = cbv[bj][j]; } else ld8(cb + (size_t)bi * 2304 + u.pn * 256 + lc, c8);
#pragma unroll
                    for (int j = 0; j < 4; ++j) { v[j] = rinv * acc[ai][bj][m][0][j] + sc * c8[j]; v[4 + j] = rinv * acc[ai][bj][m][1][j] + sc * c8[4 + j]; }
                    st8bf(dst + (size_t)row * 768 + g * 256 + lc, v);
                    if (sec > 0) {
                        if (prompt) { const int t = row & 2047; if (t >= 2048 - W) st8(wp + (((size_t)bi * W + (t - (2048 - W))) * 2 + (sec - 1)) * 256 + lc, v); }
                        else { const int rs = row - E_MP, b = rs >> 2, t = rs & 3; st8(ws + (((size_t)b * W + (W - 4 + t)) * 2 + (sec - 1)) * 256 + lc, v); }
                    }
                }
                asm volatile("" ::: "memory");
            }
        if (rdo) ride.store<4>(rv_, rd_, re_, rn_);
    }
};
struct EpiGlaIn {
    static constexpr bool PERM = true, AFTER_DRAIN = false;
    const float* rss; const float* cb;
    bf16_t* base;
    float* gd;
    EpiRide ride;
    __device__ __forceinline__ void operator()(const f32x4 (&acc)[2][2][4][2], const Unit& u, int wr, int wc, int fr, int fq) const {
        const int rL = u.pm * 13 + u.pn; const bool rdo = rL < ride.nunits; f32x4 rv_[4]; const f32x4* rs_ = nullptr; f32x4* rd_ = nullptr; unsigned re_ = 0u, rn_ = 0u;
        if (rdo) ride.load<4>(rL, (wr * 4 + wc) * 64 + fq * 16 + fr, rv_, rs_, rd_, re_, rn_);
        const int pn = u.pn;
        const size_t doff = pn < 2 ? 0 : (pn < 4 ? (WS_GK - WS_GQ) / 2 : (pn < 8 ? (WS_GV - WS_GQ) / 2 : (WS_GR - WS_GQ) / 2));
        const int ld = pn < 4 ? 512 : 1024, tcol = (pn < 2 ? pn : (pn < 4 ? pn - 2 : (pn < 8 ? pn - 4 : pn - 8))) * 256;
        bf16_t* dst = base + doff;
        const float sc = pn < 2 ? 0.08838834764831845f : 1.0f;
        const bool prompt = u.pm < 64;
        float rv[2][4], cbv[2][8];
#pragma unroll
        for (int ai = 0; ai < 2; ++ai)
#pragma unroll
            for (int m = 0; m < 4; ++m) rv[ai][m] = row_rinv(rss, u.pm * 256 + ai * 128 + wr * 64 + m * 16 + fr) * sc;
#pragma unroll
        for (int bj = 0; bj < 2; ++bj) ld8(cb + (size_t)(prompt ? (u.pm >> 3) : 0) * 3328 + pn * 256 + bj * 128 + wc * 32 + 8 * fq, cbv[bj]);
#pragma unroll
        for (int ai = 0; ai < 2; ++ai)
#pragma unroll
            for (int m = 0; m < 4; ++m) {
                const int row = u.pm * 256 + ai * 128 + wr * 64 + m * 16 + fr;
                const int bi = prompt ? (u.pm >> 3) : 8 + ((row - E_MP) >> 2);
                const float rinv = rv[ai][m];
#pragma unroll
                for (int bj = 0; bj < 2; ++bj) {
                    const int lc = bj * 128 + wc * 32 + 8 * fq;
                    float c8[8], v[8]; if (prompt) {
#pragma unroll
                        for (int j = 0; j < 8; ++j) c8[j] = cbv[bj][j]; } else ld8(cb + (size_t)bi * 3328 + pn * 256 + lc, c8);
#pragma unroll
                    for (int j = 0; j < 4; ++j) { v[j] = rinv * acc[ai][bj][m][0][j] + sc * c8[j]; v[4 + j] = rinv * acc[ai][bj][m][1][j] + sc * c8[4 + j]; }
                    if (pn < 12) st8bf(dst + (size_t)row * ld + tcol + lc, v);
                    else if (lc < 16) st8(gd + (size_t)row * 16 + lc, v);
                }
                asm volatile("" ::: "memory");
            }
        if (rdo) ride.store<4>(rv_, rd_, re_, rn_);
    }
};
}
constexpr int RING_OFF = 0, RING_BYTES = 133120;
constexpr int LDSCTL_OFF = RING_BYTES, MISC_OFF = LDSCTL_OFF + 320;
constexpr int LDS_BYTES = 147456;
constexpr int NWAVES = 8;

#define XB_TMO      128
#define XB_XCNT(j)  (256  + 64 * (j))
#define XB_XSUB(j)  (1280 + 64 * (j))
#define XB_XGEN(j)  (2304 + 64 * (j))
#define XB_TOP      3328
#define XB_TOPGEN   3392
#define XCD_BAR_WORDS 3456
#define XB_SPIN_CAP (1u << 18)
__device__ __forceinline__ unsigned xb_ld(unsigned* p)              { return __hip_atomic_load(p, __ATOMIC_RELAXED, __HIP_MEMORY_SCOPE_AGENT); }
__device__ __forceinline__ unsigned xb_add(unsigned* p, unsigned v) { return __hip_atomic_fetch_add(p, v, __ATOMIC_RELAXED, __HIP_MEMORY_SCOPE_AGENT); }
__device__ __forceinline__ unsigned xb_xcc_id() { return (unsigned)__builtin_amdgcn_s_getreg((3 << 11) | 20) & 0xFu; }
#define XB_SPIN(cond, bar) do { unsigned _sp = 0; while (cond) { __builtin_amdgcn_s_sleep(1); \
    if ((++_sp & 255u) == 0u) { if (xb_ld(&(bar)[XB_TMO])) break; if (_sp > XB_SPIN_CAP) { atomicAdd(&(bar)[XB_TMO], 1u); break; } } } } while (0)
struct XcdBarrier { unsigned* bar; unsigned x; volatile LAS unsigned* st; };
__device__ __forceinline__ XcdBarrier xcd_barrier_post(unsigned* bar, volatile LAS unsigned* st, int tid) {
    XcdBarrier b; b.bar = bar; b.x = xb_xcc_id(); b.st = st;
    if (tid == 0) (void)xb_add(&bar[XB_XCNT(b.x)], 1u);
    return b;
}
__device__ __forceinline__ void xcd_barrier_complete(unsigned* bar, unsigned x, unsigned& nloc, unsigned& nx) {
    const unsigned G = gridDim.x * gridDim.y * gridDim.z;
    unsigned sum, cnt, mine, sp = 0u;
    for (;;) {
        sum = 0u; cnt = 0u; mine = 0u;
#pragma unroll
        for (unsigned j = 0; j < 16; ++j) { const unsigned c = xb_ld(&bar[XB_XCNT(j)]); sum += c; cnt += (c > 0u) ? 1u : 0u; mine = (j == x) ? c : mine; }
        if (sum == G) break;
        __builtin_amdgcn_s_sleep(1);
        if ((++sp & 255u) == 0u) { if (xb_ld(&bar[XB_TMO])) break; if (sp > XB_SPIN_CAP) { atomicAdd(&bar[XB_TMO], 1u); break; } }
    }
    nloc = mine > 0u ? mine : 1u; nx = cnt > 0u ? cnt : 1u;
}
__device__ __forceinline__ void xcd_barrier(const XcdBarrier& b, int tid) {
    asm volatile("s_waitcnt vmcnt(0)" ::: "memory");
    __syncthreads();
    if (tid == 0) {
        unsigned* bar = b.bar;
        __builtin_amdgcn_s_waitcnt(0);
        unsigned nloc = b.st[0], nx = b.st[1];
        if (nloc == 0u) { xcd_barrier_complete(bar, b.x, nloc, nx); b.st[0] = nloc; b.st[1] = nx; }
        const unsigned old = xb_add(&bar[XB_XSUB(b.x)], 1u);
        const unsigned gen = old / nloc;
        if (old + 1u == (gen + 1u) * nloc) {
            __builtin_amdgcn_fence(__ATOMIC_RELEASE, "agent");
            asm volatile("s_waitcnt vmcnt(0)" ::: "memory");
            const unsigned og = xb_add(&bar[XB_TOP], 1u);
            const unsigned tg = og / nx;
            if (og + 1u == (tg + 1u) * nx) xb_add(&bar[XB_TOPGEN], 1u);
            else XB_SPIN(xb_ld(&bar[XB_TOPGEN]) == tg, bar);
            __builtin_amdgcn_fence(__ATOMIC_ACQUIRE, "agent");
            xb_add(&bar[XB_XGEN(b.x)], 1u);
            asm volatile("s_waitcnt vmcnt(0)" ::: "memory");
        } else {
            XB_SPIN(xb_ld(&bar[XB_XGEN(b.x)]) == gen, bar);
            __builtin_amdgcn_fence(__ATOMIC_ACQUIRE, "agent");
            asm volatile("s_waitcnt vmcnt(0)" ::: "memory");
        }
    }
    __syncthreads();
}

struct Frame {
    LAS unsigned char* lds;
    int tid, lane, wave, G, bid;
    const __attribute__((address_space(4))) unsigned char* ka;
    __device__ __forceinline__ const float* inp(int k) const { return (const float*)(*(const GAS float* const __attribute__((address_space(4)))*)(ka + 8 * k)); }
    GAS float* out_g; GAS unsigned char* ws_g;
};
#define F_WS ((unsigned char*)F.ws_g)
#define F_OUT ((float*)F.out_g)
#define WSP(T, off) ((T*)(F_WS + (off)))
#define RIDE_LOAD(N, V, CB, E0) do { _Pragma("unroll") for (int u_ = 0; u_ < (N); ++u_) { const unsigned e_ = (unsigned)(E0) + (unsigned)(u_ * 512) + (unsigned)F.tid; (V)[u_] = __builtin_nontemporal_load((CB).src + (e_ < (CB).n ? e_ : (CB).n - 1u)); } } while (0)
#define RIDE_STORE(N, V, CB, E0) do { _Pragma("unroll") for (int u_ = 0; u_ < (N); ++u_) { const unsigned e_ = (unsigned)(E0) + (unsigned)(u_ * 512) + (unsigned)F.tid; if (e_ < (CB).n) __builtin_nontemporal_store((V)[u_], (CB).dst + e_); } } while (0)

constexpr unsigned CP_SLICE_F4 = 16384u, CP_NSTATIC = 1513u;
struct CpBase { const f32x4* src; f32x4* dst; unsigned n; };
__device__ __forceinline__ CpBase copy_base(Frame& F, unsigned s) {
    const unsigned b = s >> 4, k = s & 15u, per_b = 2044u * 128u;
    CpBase c; c.src = (const f32x4*)F.inp(5) + (size_t)b * (2048 * 128) + 512 + (size_t)k * CP_SLICE_F4; c.dst = (f32x4*)(F_OUT + O_W3S) + (size_t)b * (2048 * 128) + (size_t)k * CP_SLICE_F4;
    c.n = per_b - k * CP_SLICE_F4 < CP_SLICE_F4 ? per_b - k * CP_SLICE_F4 : CP_SLICE_F4; return c;
}


__device__ __forceinline__ void p0_transpose_item(const float* W, int K, int N, bf16* WT, int ldt, int drow0, LAS float* scr, int kb, int nb, int lane) {
    const int k0 = 64 * kb, n0 = 32 * nb;
#pragma unroll
    for (int i = 0; i < 32; ++i) { const int kk = 2 * i + (lane >> 5); const int n = n0 + (lane & 31); scr[kk * 33 + (lane & 31)] = (n < N) ? W[(size_t)(k0 + kk) * N + n] : 0.f; }
    LDS_WAIT(); asm volatile("" ::: "memory");
    const int c = lane & 7;
#pragma unroll
    for (int j = 0; j < 4; ++j) { const int n = (lane >> 3) + 8 * j; const LAS float* s = scr + (8 * c) * 33 + n;
        v4u o; o.x = pk2(s[0 * 33], s[1 * 33]); o.y = pk2(s[2 * 33], s[3 * 33]); o.z = pk2(s[4 * 33], s[5 * 33]); o.w = pk2(s[6 * 33], s[7 * 33]);
        *(v4u*)(WT + (size_t)(drow0 + n) * ldt + k0 + 8 * c) = o; }
    LDS_WAIT(); asm volatile("" ::: "memory");
}
__device__ __forceinline__ void p0_prologue(Frame& F) {
    LAS float* scr = (LAS float*)(F.lds + RING_OFF + F.wave * 16384);
    const int gw = F.bid * NWAVES + F.wave, NGW = F.G * NWAVES;
    constexpr int I_FI = 16 * 176, I_QKV = 16 * 72, I_GI = 16 * 97, I_FD = 44 * 32, I_AO = 12 * 32, I_GO = 16 * 32, I_PW = 4 * 8;
    constexpr int NITEMS = 4 * I_FI + I_QKV + I_GI + 4 * I_FD + I_AO + I_GO + 8 * I_PW;
    for (int it = gw; it < NITEMS; it += NGW) {
        int r = it;
        if (r < 4 * I_FI) { const int l = r / I_FI, q = r % I_FI, kb = q / 176, nb = q % 176, n0 = 32 * nb, half = n0 / DFF, jn = n0 % DFF;
            p0_transpose_item(F.inp(24) + (size_t)l * 1024 * 5632, 1024, 5632, WSP(bf16, WS_WNF) + (size_t)l * 5632 * 1024, 1024, (jn / 128) * 256 + half * 128 + (jn % 128), scr, kb, nb, F.lane); continue; }
        r -= 4 * I_FI;
        if (r < I_QKV) { const int kb = r / 72, nb = r % 72; p0_transpose_item(F.inp(17), 1024, 2304, WSP(bf16, WS_WNF) + (size_t)22528 * 1024, 1024, 32 * nb, scr, kb, nb, F.lane); continue; }
        r -= I_QKV;
        if (r < I_GI) { const int kb = r / 97, nb = r % 97; p0_transpose_item(F.inp(19), 1024, 3088, WSP(bf16, WS_WNF) + (size_t)24832 * 1024, 1024, 32 * nb, scr, kb, nb, F.lane); continue; }
        r -= I_GI;
        if (r < 4 * I_FD) { const int l = r / I_FD, q = r % I_FD, kb = q / 32, nb = q % 32; p0_transpose_item(F.inp(27) + (size_t)l * DFF * 1024, DFF, 1024, WSP(bf16, WS_WD) + (size_t)l * 1024 * DFF, DFF, 32 * nb, scr, kb, nb, F.lane); continue; }
        r -= 4 * I_FD;
        if (r < I_AO) { const int kb = r / 32, nb = r % 32; p0_transpose_item(F.inp(18), 768, 1024, WSP(bf16, WS_WAO), 768, 32 * nb, scr, kb, nb, F.lane); continue; }
        r -= I_AO;
        if (r < I_GO) { const int kb = r / 32, nb = r % 32; p0_transpose_item(F.inp(23), 1024, 1024, WSP(bf16, WS_WGO), 1024, 32 * nb, scr, kb, nb, F.lane); continue; }
        r -= I_GO;
        { const int jg = r / I_PW, q = r % I_PW, kb = q / 8, nb = q % 8;
            p0_transpose_item(F.inp(15) + (size_t)jg * 65536, 256, 256, WSP(bf16, WS_WP) + (size_t)(jg >> 2) * 1024 * 256, 256, (jg & 3) * 256 + 32 * nb, scr, kb, nb, F.lane); }
    }
}

__device__ __forceinline__ void mod_direct_phase(Frame& F) {
    LAS bf16* A_l = (LAS bf16*)(F.lds + RING_OFF);
    float* mod = WSP(float, WS_MOD); bf16* sh = WSP(bf16, WS_SH);
    const int fr = F.lane & 15, fq = F.lane >> 4, w = F.wave;
    for (int slab = F.bid; slab < 256; slab += F.G) {
        const int l = slab >> 6, cl0 = (slab & 63) * 96;
        const float* Wl = F.inp(10) + (size_t)l * 1024 * 6144 + cl0 + 16 * w + fr;
        f32x4 acc[9];
#pragma unroll
        for (int rb = 0; rb < 9; ++rb) acc[rb] = (f32x4){0.f, 0.f, 0.f, 0.f};
#pragma unroll 1
        for (int kc = 0; kc < 4; ++kc) {
            asm volatile("" ::: "memory");
            __syncthreads();
#pragma unroll
            for (int q = 0; q < 9; ++q) { const int id = F.tid + 512 * q, row = id >> 5, c8 = (id & 31) * 8; v4u o = {0u, 0u, 0u, 0u};
                if (row < NBI) { const float* src = (row < NBP ? F.inp(8) + (size_t)row * D : F.inp(9) + (size_t)(row - NBP) * D) + 256 * kc + c8;
                    const f32x4 a = *(const f32x4*)src, b = *(const f32x4*)(src + 4); float v[8] = {a[0], a[1], a[2], a[3], b[0], b[1], b[2], b[3]};
#pragma unroll
                    for (int j = 0; j < 8; ++j) v[j] = v[j] / (1.0f + __expf(-v[j]));
                    o.x = pk2(v[0], v[1]); o.y = pk2(v[2], v[3]); o.z = pk2(v[4], v[5]); o.w = pk2(v[6], v[7]); }
                *(LAS v4u*)(A_l + row * 264 + c8) = o; }
            __syncthreads();
            if (w < 6) {
                const float* wp = Wl + (size_t)(256 * kc + 8 * fq) * 6144;
#pragma unroll 1
                for (int kh = 0; kh < 2; ++kh) {
                    float bw[4][8];
#pragma unroll
                    for (int ks = 0; ks < 4; ++ks)
#pragma unroll
                        for (int j = 0; j < 8; ++j) bw[ks][j] = wp[(size_t)(32 * ks + j) * 6144];
#pragma unroll
                    for (int ks = 0; ks < 4; ++ks) {
                        v4u bp; bp.x = pk2(bw[ks][0], bw[ks][1]); bp.y = pk2(bw[ks][2], bw[ks][3]); bp.z = pk2(bw[ks][4], bw[ks][5]); bp.w = pk2(bw[ks][6], bw[ks][7]);
                        const bf16x8 bfrag = __builtin_bit_cast(bf16x8, bp);
#pragma unroll
                        for (int rb = 0; rb < 9; ++rb) { const bf16x8 a = *(const LAS bf16x8*)(A_l + (16 * rb + fr) * 264 + 128 * kh + 32 * ks + 8 * fq); acc[rb] = MFMA16(a, bfrag, acc[rb]); }
                    }
                    wp += (size_t)128 * 6144;
                    asm volatile("" ::: "memory");
                }
            }
        }
        if (w < 6) {
            const int col = cl0 + 16 * w + fr, mi = col >> 10, cc = col & 1023;
            const int variant = (mi == 3) ? l : ((mi == 0 && l == 1) ? 4 : ((mi == 0 && l == 2) ? 5 : -1));
            const float bias = F.inp(11)[l * 6144 + col];
#pragma unroll
            for (int rb = 0; rb < 9; ++rb)
#pragma unroll
                for (int j = 0; j < 4; ++j) { const int row = 16 * rb + 4 * fq + j; const float v = acc[rb][j] + bias;
                    if (row < NBI) mod[(size_t)row * MODLD + l * 6144 + col] = v;
                    if (variant >= 0) sh[((size_t)variant * 256 + row) * 1024 + cc] = (bf16)(pk2(v, 0.f) & 0xffffu); }
        }
    }
}
template <int W, int NNEW, bool SAMPLE>
__device__ __forceinline__ void pool_march(const float* xrow0  , int t0, const float* past  ,
                                           const LAS float* rinv_l, int c0, float G0, float G1, float sh0, float sh1, bf16* drow0  , float* st_out  , int st_first  ) {
    float r0[W], r1[W]; float s0 = 0.f, s1 = 0.f;
#pragma unroll
    for (int j = 0; j < W; ++j) { r0[j] = 0.f; r1[j] = 0.f; }
    constexpr int NTOT = 15 + NNEW, NBLK = (NTOT + 15) / 16;
#define POOL_LOAD(BLK, XV) do { _Pragma("unroll") for (int jj = 0; jj < 16; ++jj) { const int i = (BLK) * 16 + jj < NTOT ? (BLK) * 16 + jj : NTOT - 1;        \
            if (SAMPLE) (XV)[jj] = (i < 15) ? *(const f32x2*)(past + (size_t)i * D + c0) : *(const f32x2*)(xrow0 + (size_t)(i - 15) * D + c0); \
            else { const int t = t0 - 15 + i; (XV)[jj] = *(const f32x2*)(xrow0 + (size_t)(t >= 0 ? t : 0) * D + c0); } } } while (0)
    f32x2 xa[16], xb[16]; POOL_LOAD(0, xa);
#pragma unroll
    for (int blk = 0; blk < NBLK; ++blk) {
        if (blk + 1 < NBLK) { if (blk & 1) POOL_LOAD(blk + 1, xa); else POOL_LOAD(blk + 1, xb); }
        const f32x2 (&xv)[16] = (blk & 1) ? xb : xa;
#pragma unroll
        for (int jj = 0; jj < 16; ++jj) { const int i = blk * 16 + jj;
            if (i < NTOT) {
                float h0 = 0.f, h1 = 0.f;
                if (SAMPLE) { if (i < 15) { h0 = xv[jj].x; h1 = xv[jj].y; } else { const float r = rinv_l[i - 15]; h0 = xv[jj].x * r * G0 + sh0; h1 = xv[jj].y * r * G1 + sh1; } }
                else { const int t = t0 - 15 + i; if (t >= 0) { const float r = rinv_l[i]; h0 = xv[jj].x * r * G0 + sh0; h1 = xv[jj].y * r * G1 + sh1; } }
                const int slot = i % W;
                s0 += h0 - r0[slot]; r0[slot] = h0; s1 += h1 - r1[slot]; r1[slot] = h1;
                if (i >= 15) {
                    const int tn = i - 15;
                    float cnt = (float)W;
                    if (!SAMPLE) { const int t = t0 + tn; cnt = (float)(t + 1 < W ? t + 1 : W); }
                    const float ic = 1.0f / cnt;
                    *(unsigned*)(drow0 + (size_t)tn * D + c0) = pk2(s0 * ic - h0, s1 * ic - h1);
                    if (SAMPLE) { if (st_out) *(f32x2*)(st_out + (size_t)(11 + tn) * D + c0) = (f32x2){h0, h1}; }
                    else if (st_out) { const int t = t0 + tn; if (t >= st_first) *(f32x2*)(st_out + (size_t)(t - st_first) * D + c0) = (f32x2){h0, h1}; }
                } else if (SAMPLE) {
                    if (st_out && i >= 4) *(f32x2*)(st_out + (size_t)(i - 4) * D + c0) = (f32x2){h0, h1};
                }
            } }
    }
}
__device__ __forceinline__ float row_sumsq(const float* xr, int lane) {
    float s = 0.f;
#pragma unroll
    for (int j = 0; j < 4; ++j) { const f32x4 v = *(const f32x4*)(xr + 4 * lane + 256 * j); s += (v[0] * v[0] + v[1] * v[1]) + (v[2] * v[2] + v[3] * v[3]); }
    return wave_sum(s);
}
#undef POOL_LOAD
__device__ __forceinline__ void pool_diff_phase(Frame& F, int l, int j, const float* xp, const float* xs  , const float* rs  , bool bal  ) {
    LAS float* rinv_l = (LAS float*)(F.lds + RING_OFF);
    const float* mod = WSP(float, WS_MOD);
    bf16* dp = WSP(bf16, WS_DP);
    const int c0 = 2 * F.tid, grp = F.tid >> 7;
    const float ng0 = F.inp(12)[(l * 2 + 0) * D + c0], ng1 = F.inp(12)[(l * 2 + 0) * D + c0 + 1];
    const int nu = bal ? (F.bid < 110 ? 0 : (F.bid < 220 ? 2 : 1)) : (NBP * 32 - F.bid + F.G - 1) / F.G;
    for (int ku = 0; ku < nu; ++ku) {
        const int uidx = bal ? (ku == 0 ? F.bid : F.bid - 110) : F.bid + ku * F.G;
        const int b = uidx >> 5, ch = uidx & 31, t0 = 64 * ch;
        const float* xseq = xp + (size_t)b * TP * D;
        const bool ride = (F.G == 256); const CpBase cpb = copy_base(F, 512u + (unsigned)uidx); f32x4 cpv[8];
        if (ride) { asm volatile("" : "+v"(F.tid)); RIDE_LOAD(8, cpv, cpb, j * 8192); }
        __syncthreads();
        if (rs) { if (F.tid < 79) { const int t = t0 - 15 + F.tid; rinv_l[F.tid] = t >= 0 ? __builtin_amdgcn_rsqf(rs[(size_t)b * TP + t] * (1.0f / D) + EPS) : 0.f; } }
        else {
#pragma unroll
            for (int hf = 0; hf < 1; ++hf) {
                f32x4 xr[10][4];
#pragma unroll
                for (int k = 0; k < 10; ++k) { const int i = F.wave + 8 * (10 * hf + k), ic = i < 79 ? i : 78, t = t0 - 15 + ic; const float* xrp = xseq + (size_t)(t >= 0 ? t : 0) * D + 4 * F.lane;
#pragma unroll
                    for (int q = 0; q < 4; ++q) xr[k][q] = *(const f32x4*)(xrp + 256 * q); }
#pragma unroll
                for (int k = 0; k < 10; ++k) { const int i = F.wave + 8 * (10 * hf + k), t = t0 - 15 + i; float sq = 0.f;
#pragma unroll
                    for (int q = 0; q < 4; ++q) { const f32x4 v = xr[k][q]; sq += (v[0] * v[0] + v[1] * v[1]) + (v[2] * v[2] + v[3] * v[3]); }
                    sq = wave_sum(sq);
                    const float r = t >= 0 ? __builtin_amdgcn_rsqf(sq * (1.0f / D) + EPS) : 0.f;
                    if (F.lane == 0 && i < 79) rinv_l[i] = r; }
            }
        }
        __syncthreads();
        if (ride) { asm volatile("" : "+v"(F.tid)); RIDE_STORE(8, cpv, cpb, j * 8192); asm volatile("" : "+v"(F.tid)); RIDE_LOAD(8, cpv, cpb, j * 8192 + 4096); }
        const float* mrow = mod + (size_t)b * MODLD + l * 6144;
        const float G0 = ng0 * (1.0f + mrow[1024 + c0]), G1 = ng1 * (1.0f + mrow[1024 + c0 + 1]), sh0 = mrow[c0], sh1 = mrow[c0 + 1];
        bf16* drow0 = dp + ((size_t)b * TP + t0) * D;
        float* st = (ch == 31) ? F_OUT + O_POOLP + ((size_t)j * NBP + b) * 15 * D : nullptr;
        if (grp == 0)      pool_march<2, 64, false>(xseq, t0, nullptr, rinv_l, c0, G0, G1, sh0, sh1, drow0, st, TP - 15);
        else if (grp == 1) pool_march<4, 64, false>(xseq, t0, nullptr, rinv_l, c0, G0, G1, sh0, sh1, drow0, st, TP - 15);
        else if (grp == 2) pool_march<8, 64, false>(xseq, t0, nullptr, rinv_l, c0, G0, G1, sh0, sh1, drow0, st, TP - 15);
        else               pool_march<16, 64, false>(xseq, t0, nullptr, rinv_l, c0, G0, G1, sh0, sh1, drow0, st, TP - 15);
        if (ride) { asm volatile("" : "+v"(F.tid)); RIDE_STORE(8, cpv, cpb, j * 8192 + 4096); }
    }
    for (int b = bal ? (F.bid < 110 ? F.bid : (F.bid >= 220 && F.bid < 238 ? F.bid - 110 : -1)) : (F.G >= 2 * NBS ? F.bid - NBS : F.bid); b < NBS; b += F.G) {
        if (b < 0) continue;
        const float* xrow0 = xs + ((size_t)MP + 4 * b) * D;
        __syncthreads();
        if (rs) { if (F.tid < 4) rinv_l[F.tid] = __builtin_amdgcn_rsqf(rs[(size_t)MP + 4 * b + F.tid] * (1.0f / D) + EPS); }
        else if (F.wave < 4) { const float r = __builtin_amdgcn_rsqf(row_sumsq(xrow0 + (size_t)F.wave * D, F.lane) * (1.0f / D) + EPS); if (F.lane == 0) rinv_l[F.wave] = r; }
        __syncthreads();
        const float* mrow = mod + (size_t)(NBP + b) * MODLD + l * 6144;
        const float G0 = ng0 * (1.0f + mrow[1024 + c0]), G1 = ng1 * (1.0f + mrow[1024 + c0 + 1]), sh0 = mrow[c0], sh1 = mrow[c0 + 1];
        const float* past = F.inp(2) + ((size_t)j * NBS + b) * 15 * D;
        bf16* drow0 = dp + ((size_t)MP + 4 * b) * D;
        float* st = F_OUT + O_POOLS + ((size_t)j * NBS + b) * 15 * D;
        if (grp == 0)      pool_march<2, 4, true>(xrow0, 0, past, rinv_l, c0, G0, G1, sh0, sh1, drow0, st, 0);
        else if (grp == 1) pool_march<4, 4, true>(xrow0, 0, past, rinv_l, c0, G0, G1, sh0, sh1, drow0, st, 0);
        else if (grp == 2) pool_march<8, 4, true>(xrow0, 0, past, rinv_l, c0, G0, G1, sh0, sh1, drow0, st, 0);
        else               pool_march<16, 4, true>(xrow0, 0, past, rinv_l, c0, G0, G1, sh0, sh1, drow0, st, 0);
    }
}

__device__ __forceinline__ void ffn_fixup_phase(Frame& F, int l) {
    const float* hg = WSP(float, WS_HG); const float* hu = WSP(float, WS_HU); const float* tg = WSP(float, WS_TG);
    bf16* act = WSP(bf16, WS_ACT);
    const float* cw = F.inp(25) + (size_t)l * 3 * DFF; const float* cbv = F.inp(26) + (size_t)l * DFF;
    for (int s = F.bid; s < 256; s += F.G) {
        const bool first = (s & 31) == 0;
        const size_t sp = (size_t)(first ? s : s - 1);
        float gm2[6], gm1[6], g0[6], g1[6], u0[6], u1[6], w0[6], w1[6], w2[6], bb[6];
#pragma unroll
        for (int k = 0; k < 6; ++k) { const int colr = F.tid + 512 * k, col = colr < DFF ? colr : DFF - 1;
            gm2[k] = tg[(sp * 2 + 0) * DFF + col]; gm1[k] = tg[(sp * 2 + 1) * DFF + col];
            g0[k] = hg[((size_t)s * 2 + 0) * DFF + col]; g1[k] = hg[((size_t)s * 2 + 1) * DFF + col];
            u0[k] = hu[((size_t)s * 2 + 0) * DFF + col]; u1[k] = hu[((size_t)s * 2 + 1) * DFF + col];
            w0[k] = cw[col]; w1[k] = cw[DFF + col]; w2[k] = cw[2 * DFF + col]; bb[k] = cbv[col]; }
#pragma unroll
        for (int k = 0; k < 6; ++k) { const int col = F.tid + 512 * k;
            const float m2 = first ? 0.f : gm2[k], m1 = first ? 0.f : gm1[k];
            const float a0 = pg8::gelu1(w0[k] * m2 + w1[k] * m1 + w2[k] * g0[k] + bb[k]) * u0[k];
            const float a1 = pg8::gelu1(w0[k] * m1 + w1[k] * g0[k] + w2[k] * g1[k] + bb[k]) * u1[k];
            if (col < DFF) { act[(size_t)(64 * s) * DFF + col] = (bf16)(pk2(a0, 0.f) & 0xffffu); act[(size_t)(64 * s + 1) * DFF + col] = (bf16)(pk2(a1, 0.f) & 0xffffu); } }
    }
}


__device__ __forceinline__ int t5_bucket(int dist) {
    if (dist < 16) return dist;
    const float df = (float)dist;
    int large = 16 + (int)(logf(df / 16.0f) / 4.852030263919617f * 16.0f);
    return large < 31 ? large : 31;
}
__device__ __forceinline__ void attn_block(Frame& F, int b, int hs, int g, int rho, int d, int i0) {
    LAS bf16* Ks = (LAS bf16*)(F.lds + RING_OFF);
    LAS bf16* Vt = (LAS bf16*)(F.lds + RING_OFF + 36864);
    const LAS float* bias_l = (const LAS float*)(F.lds + RING_OFF + 72704) + (g * 4 + hs) * 132;
    const bf16* QB = WSP(bf16, WS_QB); const bf16* KB = WSP(bf16, WS_KB); const bf16* VB = WSP(bf16, WS_VB);
    bf16* AO = WSP(bf16, WS_AO); float* LSE = WSP(float, WS_LSE);
    const int colq = g * 256 + hs * 64;
    const int fr = F.lane & 15, fq = F.lane >> 4;
#pragma unroll
    for (int j = 0; j < 4; ++j) {
        const int id = F.tid + 512 * j, key = id >> 3, part = id & 7, ki = i0 - 128 + key;
        v4u kv = {0u, 0u, 0u, 0u}, vv = {0u, 0u, 0u, 0u};
        if (ki >= 0) { const size_t row = (size_t)b * TP + rho + d * ki; kv = *(const v4u*)(KB + row * 768 + colq + part * 8); vv = *(const v4u*)(VB + row * 768 + colq + part * 8); }
        *(LAS v4u*)(Ks + key * 72 + part * 8) = kv;
        LAS bf16* vt = Vt + (part * 8) * 264 + key;
        vt[0 * 264] = (bf16)(vv.x & 0xffffu); vt[1 * 264] = (bf16)(vv.x >> 16); vt[2 * 264] = (bf16)(vv.y & 0xffffu); vt[3 * 264] = (bf16)(vv.y >> 16);
        vt[4 * 264] = (bf16)(vv.z & 0xffffu); vt[5 * 264] = (bf16)(vv.z >> 16); vt[6 * 264] = (bf16)(vv.w & 0xffffu); vt[7 * 264] = (bf16)(vv.w >> 16);
    }
    __syncthreads();
    const int w = F.wave, ql = 16 * w + fr;
    const size_t rowq = (size_t)b * TP + rho + d * (i0 + ql);
    bf16x8 qf[2];
    qf[0] = *(const bf16x8*)(QB + rowq * 768 + colq + 8 * fq); qf[1] = *(const bf16x8*)(QB + rowq * 768 + colq + 32 + 8 * fq);
    float sc[9][4]; float mx = -1e30f;
#pragma unroll
    for (int jt = 0; jt < 9; ++jt) {
        const int tile = w + jt;
        f32x4 acc = {0.f, 0.f, 0.f, 0.f};
#pragma unroll
        for (int s = 0; s < 2; ++s) { const bf16x8 a = *(const LAS bf16x8*)(Ks + (16 * tile + fr) * 72 + 32 * s + 8 * fq); acc = MFMA16(a, qf[s], acc); }
#pragma unroll
        for (int j = 0; j < 4; ++j) { const int kl = 16 * tile + 4 * fq + j, dist = ql + 128 - kl; const bool valid = dist >= 0 && dist <= 128 && (i0 - 128 + kl) >= 0;
            const float v = valid ? acc[j] + bias_l[valid ? dist : 0] : -1e30f; sc[jt][j] = v; mx = v > mx ? v : mx; }
    }
    { const float o1 = __shfl_xor(mx, 16); mx = o1 > mx ? o1 : mx; const float o2 = __shfl_xor(mx, 32); mx = o2 > mx ? o2 : mx; }
    float sum = 0.f;
#pragma unroll
    for (int jt = 0; jt < 9; ++jt)
#pragma unroll
        for (int j = 0; j < 4; ++j) { const float e = __expf(sc[jt][j] - mx); sc[jt][j] = e; sum += e; }
    sum += __shfl_xor(sum, 16); sum += __shfl_xor(sum, 32);
    const float inv = 1.0f / sum, lse = mx + __logf(sum);
    f32x4 o[4];
#pragma unroll
    for (int db = 0; db < 4; ++db) o[db] = (f32x4){0.f, 0.f, 0.f, 0.f};
#pragma unroll
    for (int pp = 0; pp < 5; ++pp) {
        const int ta = w + 2 * pp, tb = ta + 1; const bool hasb = (2 * pp + 1) < 9;
        v4u pb; pb.x = pk2(sc[2 * pp][0] * inv, sc[2 * pp][1] * inv); pb.y = pk2(sc[2 * pp][2] * inv, sc[2 * pp][3] * inv);
        if (hasb) { pb.z = pk2(sc[hasb ? 2 * pp + 1 : 0][0] * inv, sc[hasb ? 2 * pp + 1 : 0][1] * inv); pb.w = pk2(sc[hasb ? 2 * pp + 1 : 0][2] * inv, sc[hasb ? 2 * pp + 1 : 0][3] * inv); } else { pb.z = 0u; pb.w = 0u; }
        const bf16x8 pB = __builtin_bit_cast(bf16x8, pb);
#pragma unroll
        for (int db = 0; db < 4; ++db) {
            const LAS bf16* vr = Vt + (16 * db + fr) * 264 + 4 * fq;
            const v2u lo = *(const LAS v2u*)(vr + 16 * ta); v2u hi = {0u, 0u}; if (hasb) hi = *(const LAS v2u*)(vr + 16 * tb);
            const v4u av = {lo.x, lo.y, hi.x, hi.y};
            o[db] = MFMA16(__builtin_bit_cast(bf16x8, av), pB, o[db]);
        }
    }
#pragma unroll
    for (int db = 0; db < 4; ++db) { v2u ov; ov.x = pk2(o[db][0], o[db][1]); ov.y = pk2(o[db][2], o[db][3]); *(v2u*)(AO + rowq * 768 + colq + 16 * db + 4 * fq) = ov; }
    if (fq == 0) LSE[rowq * 12 + g * 4 + hs] = lse;
    __syncthreads();
}
__device__ __forceinline__ void attn_sample_task(Frame& F, int G, int tok, int hs, LAS float* sc_l, const LAS float* bias_t) {
    const int d = 1 << (2 * G), W = 128 << (2 * G);
    const float* cache = F.inp(3 + G);
    const bf16* QB = WSP(bf16, WS_QB); const bf16* KB = WSP(bf16, WS_KB); const bf16* VB = WSP(bf16, WS_VB);
    bf16* AO = WSP(bf16, WS_AO); float* LSE = WSP(float, WS_LSE);
    const int b = tok >> 2, t = tok & 3;
    const int kq = F.lane >> 4, dl = F.lane & 15, colq = G * 256 + hs * 64;
    const size_t rowq = (size_t)MP + tok;
    f32x4 q4; { const v2u qw = *(const v2u*)(QB + rowq * 768 + colq + 4 * dl); q4 = (f32x4){bflo(qw.x), bfhi(qw.x), bflo(qw.y), bfhi(qw.y)}; }
    const float* crow = cache + ((size_t)b * W - (size_t)(TP - W)) * 512 + hs * 64 + 4 * dl;
    f32x4 kk[33];
    { const int pos = TP + t - kq * d;
      if (pos >= TP) { const v2u kw = *(const v2u*)(KB + ((size_t)MP + 4 * b + (pos - TP)) * 768 + colq + 4 * dl); kk[0] = (f32x4){bflo(kw.x), bfhi(kw.x), bflo(kw.y), bfhi(kw.y)}; }
      else kk[0] = *(const f32x4*)(crow + (size_t)pos * 512); }
    const float* krow = crow + (size_t)(TP + t - kq * d) * 512;
#pragma unroll
    for (int it = 1; it < 32; ++it) kk[it] = *(const f32x4*)(krow - (size_t)it * (size_t)(2048 * d));
    kk[32] = *(const f32x4*)(crow + (size_t)(TP + t - 128 * d) * 512);
    float mx = -1e30f;
    const LAS float* bias_j = bias_t + (G * 4 + hs) * 132 + kq;
#pragma unroll
    for (int it = 0; it < 33; ++it) {
        float s = (q4[0] * kk[it][0] + q4[1] * kk[it][1]) + (q4[2] * kk[it][2] + q4[3] * kk[it][3]);
        s += __shfl_xor(s, 1); s += __shfl_xor(s, 2); s += __shfl_xor(s, 4); s += __shfl_xor(s, 8);
        if (it < 32) { s += bias_j[4 * it]; mx = s > mx ? s : mx; if (dl == 0) sc_l[4 * it + kq] = s; }
        else if (kq == 0) { s += bias_j[128]; mx = s > mx ? s : mx; if (dl == 0) sc_l[128] = s; }
    }
    { const float o1 = __shfl_xor(mx, 16); mx = o1 > mx ? o1 : mx; const float o2 = __shfl_xor(mx, 32); mx = o2 > mx ? o2 : mx; }
    asm volatile("" ::: "memory");
    f32x4 vv[33];
    { const int pos = TP + t - kq * d;
      if (pos >= TP) { const v2u vw = *(const v2u*)(VB + ((size_t)MP + 4 * b + (pos - TP)) * 768 + colq + 4 * dl); vv[0] = (f32x4){bflo(vw.x), bfhi(vw.x), bflo(vw.y), bfhi(vw.y)}; }
      else vv[0] = *(const f32x4*)(crow + (size_t)pos * 512 + 256); }
#pragma unroll
    for (int it = 1; it < 32; ++it) vv[it] = *(const f32x4*)(krow - (size_t)it * (size_t)(2048 * d) + 256);
    vv[32] = *(const f32x4*)(crow + (size_t)(TP + t - 128 * d) * 512 + 256);
    LDS_WAIT(); asm volatile("" ::: "memory");
    float sum = 0.f; f32x4 o = {0.f, 0.f, 0.f, 0.f};
#pragma unroll
    for (int it = 0; it < 33; ++it) {
        float e = __expf(sc_l[it < 32 ? 4 * it + kq : 128] - mx); if (it == 32 && kq != 0) e = 0.f;
        sum += e; o += vv[it] * e;
    }
    sum += __shfl_xor(sum, 16); sum += __shfl_xor(sum, 32);
#pragma unroll
    for (int e = 0; e < 4; ++e) { o[e] += __shfl_xor(o[e], 16); o[e] += __shfl_xor(o[e], 32); }
    const float inv = 1.0f / sum, lse = mx + __logf(sum);
    if (kq == 0) { v2u ov; ov.x = pk2(o[0] * inv, o[1] * inv); ov.y = pk2(o[2] * inv, o[3] * inv); *(v2u*)(AO + rowq * 768 + colq + 4 * dl) = ov; }
    if (F.lane == 0) LSE[rowq * 12 + G * 4 + hs] = lse;
    LDS_WAIT(); asm volatile("" ::: "memory");
}
constexpr unsigned CP_SLICE = 16384u, CP_NSLICES = 128u * 16u + 128u * 4u + 128u;
constexpr int CW_CPHEAD = 8192;
__device__ __forceinline__ void copy_slice(Frame& F, unsigned s) {
    const f32x4* src; f32x4* dst; unsigned per_b, k;
    if (s < 2048u) { const unsigned b = s >> 4; k = s & 15u; per_b = 2044u * 128u; src = (const f32x4*)F.inp(5) + (size_t)b * (2048 * 128) + 512; dst = (f32x4*)(F_OUT + O_W3S) + (size_t)b * (2048 * 128); }
    else if (s < 2560u) { const unsigned q = s - 2048u, b = q >> 2; k = q & 3u; per_b = 508u * 128u; src = (const f32x4*)F.inp(4) + (size_t)b * (512 * 128) + 512; dst = (f32x4*)(F_OUT + O_W2S) + (size_t)b * (512 * 128); }
    else { const unsigned b = s - 2560u; k = 0u; per_b = 124u * 128u; src = (const f32x4*)F.inp(3) + (size_t)b * (128 * 128) + 512; dst = (f32x4*)(F_OUT + O_W1S) + (size_t)b * (128 * 128); }
    const unsigned base = k * CP_SLICE + F.tid;
#pragma unroll 1
    for (int bt = 0; bt < 2; ++bt) {
        f32x4 v[16];
#pragma unroll
        for (int u = 0; u < 16; ++u) { const unsigned i = base + (unsigned)(bt * 16 + u) * 512u; if (i < per_b) v[u] = __builtin_nontemporal_load(src + i); }
#pragma unroll
        for (int u = 0; u < 16; ++u) { const unsigned i = base + (unsigned)(bt * 16 + u) * 512u; if (i < per_b) __builtin_nontemporal_store(v[u], dst + i); }
    }
}
__device__ __forceinline__ void copy_pull(Frame& F, int n) {
    LAS unsigned* sh = (LAS unsigned*)(F.lds + MISC_OFF) + 16;
    unsigned* head = (unsigned*)(F_WS + WS_CTL) + CW_CPHEAD;
    for (;;) {
        const int take = n > 0 ? n : 2;
        LDS_BARRIER();
        if (F.tid == 0) *sh = __hip_atomic_fetch_add(head, (unsigned)take, __ATOMIC_RELAXED, __HIP_MEMORY_SCOPE_AGENT);
        LDS_BARRIER();
        const unsigned s0 = *sh + (F.G == 256 ? CP_NSTATIC : 0u);
        if (s0 >= CP_NSLICES) break;
        for (unsigned s = s0; s < s0 + (unsigned)take && s < CP_NSLICES; ++s) copy_slice(F, s);
        if (n > 0) break;
    }
}
__device__ __forceinline__ void attn_phase(Frame& F) {
    { LAS float* bt = (LAS float*)(F.lds + RING_OFF + 72704);
      for (int i = F.tid; i < 12 * 129; i += 512) { const int hd = i / 129, j = i % 129; bt[hd * 132 + j] = F.inp(14)[t5_bucket(j << (2 * (hd >> 2))) * 12 + hd]; }
      __syncthreads(); }
    const int vcu = (F.G % 8 == 0) ? (F.bid % 8) * (F.G / 8) + F.bid / 8 : F.bid;
    for (int idx = vcu; idx < 1536; idx += F.G) {
        const int b = idx / 192, r = idx % 192, hs = r / 48, r2 = r % 48, g = r2 / 16, sub = r2 % 16;
        const int d = 1 << (2 * g), rho = g == 0 ? 0 : (g == 1 ? (sub >> 2) : sub), i0 = g == 0 ? 128 * sub : (g == 1 ? 128 * (sub & 3) : 0);
        const int it = (idx - vcu) / F.G; const bool ride = (F.G == 256) && it < 6;
        const CpBase cpb = copy_base(F, it < 4 ? (unsigned)F.bid : 1024u + ((unsigned)F.bid >> 1)); const int e0 = it < 4 ? it * 4096 : (F.bid & 1) * 8192 + (it - 4) * 4096;
        f32x4 cpv[8];
        if (ride) RIDE_LOAD(8, cpv, cpb, e0);
        attn_block(F, b, hs, g, rho, d, i0);
        if (ride) RIDE_STORE(8, cpv, cpb, e0);
    }
    LAS float* sc_l = (LAS float*)(F.lds + RING_OFF) + F.wave * 160; const LAS float* bias_t = (const LAS float*)(F.lds + RING_OFF + 72704);
    const int gw = F.bid * NWAVES + F.wave, ngw = F.G * NWAVES;
    for (int task = gw; task < MS * 12; task += ngw) attn_sample_task(F, task / (MS * 4), (task % (MS * 4)) >> 2, task & 3, sc_l, bias_t);
}
__device__ __forceinline__ void attn_merge_phase(Frame& F) {
    bf16* AO = WSP(bf16, WS_AO); const float* LSE = WSP(float, WS_LSE);
    const size_t nt = (size_t)F.G * 512;
    for (size_t i0 = (size_t)F.bid * 512 + F.tid; i0 < (size_t)M * 96; i0 += 8 * nt) {
        v4u w[8]; float l0[8], l1[8], l2[8];
#pragma unroll
        for (int u = 0; u < 8; ++u) { const size_t i = i0 + u * nt < (size_t)M * 96 ? i0 + u * nt : i0; const size_t row = i / 96; const int col = (int)(i % 96) * 8, hs = (col & 255) >> 6;
            w[u] = *(const v4u*)(AO + row * 768 + col); l0[u] = LSE[row * 12 + hs]; l1[u] = LSE[row * 12 + 4 + hs]; l2[u] = LSE[row * 12 + 8 + hs]; }
#pragma unroll
        for (int u = 0; u < 8; ++u) { const size_t i = i0 + u * nt; if (i < (size_t)M * 96) { const size_t row = i / 96; const int col = (int)(i % 96) * 8, g = col >> 8;
            const float mx = fmaxf(l0[u], fmaxf(l1[u], l2[u])), e0 = __expf(l0[u] - mx), e1 = __expf(l1[u] - mx), e2 = __expf(l2[u] - mx);
            const float al = (g == 0 ? e0 : (g == 1 ? e1 : e2)) / (e0 + e1 + e2);
            v4u o; o.x = pk2(bflo(w[u].x) * al, bfhi(w[u].x) * al); o.y = pk2(bflo(w[u].y) * al, bfhi(w[u].y) * al); o.z = pk2(bflo(w[u].z) * al, bfhi(w[u].z) * al); o.w = pk2(bflo(w[u].w) * al, bfhi(w[u].w) * al);
            *(v4u*)(AO + row * 768 + col) = o; } }
    }
}

__device__ __forceinline__ void rider_res(Frame& F, const pg8::Gemm g, const pg8::EpiRes E) {
    LAS float* part = (LAS float*)(F.lds + RING_OFF);
    const int fr = F.lane & 15, fq = F.lane >> 4, w = F.wave;
    const int kw = g.K >> 3, nks = kw >> 5;
    for (int piece = F.bid; piece < 256; piece += F.G) {
        const int rg = piece >> 4, cg = piece & 15;
        const bf16* Ab = g.A + (size_t)(MP + 32 * rg + fr) * g.lda + (size_t)g.a_pn * (cg >> 2) + (size_t)w * kw + 8 * fq;
        const bf16* Bb = g.Bt + (size_t)(64 * cg + fr) * g.ldb + (size_t)w * kw + 8 * fq;
        f32x4 acc[2][4];
#pragma unroll
        for (int rb = 0; rb < 2; ++rb)
#pragma unroll
            for (int cb = 0; cb < 4; ++cb) acc[rb][cb] = (f32x4){0.f, 0.f, 0.f, 0.f};
        for (int ks0 = 0; ks0 < nks; ks0 += 4) {
            bf16x8 a[4][2], b[4][4];
#pragma unroll
            for (int i = 0; i < 4; ++i) { const int ks = (ks0 + i < nks) ? ks0 + i : nks - 1;
#pragma unroll
                for (int rb = 0; rb < 2; ++rb) a[i][rb] = *(const bf16x8*)(Ab + (size_t)(16 * rb) * g.lda + 32 * ks);
#pragma unroll
                for (int cb = 0; cb < 4; ++cb) b[i][cb] = *(const bf16x8*)(Bb + (size_t)(16 * cb) * g.ldb + 32 * ks); }
#pragma unroll
            for (int i = 0; i < 4; ++i) if (ks0 + i < nks) {
#pragma unroll
                for (int rb = 0; rb < 2; ++rb)
#pragma unroll
                    for (int cb = 0; cb < 4; ++cb) acc[rb][cb] = MFMA16(a[i][rb], b[i][cb], acc[rb][cb]); }
        }
        __syncthreads();
#pragma unroll
        for (int rb = 0; rb < 2; ++rb)
#pragma unroll
            for (int cb = 0; cb < 4; ++cb) *(LAS f32x4*)(part + ((w * 8 + rb * 4 + cb) * 64 + F.lane) * 4) = acc[rb][cb];
        __syncthreads();
        const int rb = w >> 2, cb = w & 3;
        f32x4 v = {0.f, 0.f, 0.f, 0.f};
#pragma unroll
        for (int ww = 0; ww < 8; ++ww) v += *(const LAS f32x4*)(part + ((ww * 8 + w) * 64 + F.lane) * 4);
        const int col = 64 * cg + 16 * cb + fr;
        const float ps = E.pscale ? E.pscale[col] : 1.0f, ng = E.ngain ? E.ngain[col] : 0.f;
#pragma unroll
        for (int j = 0; j < 4; ++j) {
            const int rl = 16 * rb + 4 * fq + j, row = MP + 32 * rg + rl, bi = NBP + ((row - MP) >> 2);
            const float xn = E.xin_s[(size_t)row * D + col] + E.gate[(size_t)bi * MODLD + col] * ps * v[j];
            E.xout[(size_t)row * D + col] = xn;
            if (E.ngain) E.an[(size_t)row * D + col] = (bf16)(pk2(xn * (ng * (1.0f + E.nscale[(size_t)bi * MODLD + col])), 0.f) & 0xffffu);
            float ss = xn * xn;
            ss += __shfl_xor(ss, 1); ss += __shfl_xor(ss, 2); ss += __shfl_xor(ss, 4); ss += __shfl_xor(ss, 8);
            if (fr == 0) atomicAdd(E.rss + row, ss);
        }
    }
}

__device__ __forceinline__ float log_sigmoid(float z) { return fminf(z, 0.f) - log1pf(__expf(-fabsf(z))); }
__device__ __forceinline__ float log_sigmoid_fast(float z) { return fminf(z, 0.f) - __logf(1.0f + __expf(-fabsf(z))); }
__device__ __forceinline__ void gla_prep_phase(Frame& F) {
    LAS bf16* Qd_l = (LAS bf16*)(F.lds + RING_OFF);
    LAS bf16* Kd_l = (LAS bf16*)(F.lds + RING_OFF + 66560);
    const bf16* GQ = WSP(bf16, WS_GQ); const bf16* GK = WSP(bf16, WS_GK); const float* GD = WSP(float, WS_GD);
    bf16* QD = WSP(bf16, WS_QD); bf16* KET = WSP(bf16, WS_KET); bf16* ATT = WSP(bf16, WS_ATT); float* DEC = WSP(float, WS_DEC);
    const int col = F.tid;
    float wg[16];
#pragma unroll
    for (int j = 0; j < 16; ++j) wg[j] = F.inp(20)[j * 512 + col];
    const float bg = F.inp(21)[col];
    for (int cidx = F.bid; cidx < NBP * 32; cidx += F.G) {
        const size_t r0 = (size_t)cidx * 64;
        __syncthreads();
        float bc = 0.f;
        const bool ride = (F.G == 256) && cidx == F.bid; const CpBase cpb = copy_base(F, 256u + (unsigned)F.bid);
#define PREP_LOAD(S8, QV, KV, ZZ) do { \
            _Pragma("unroll") for (int e = 0; e < 8; ++e) { (QV)[e] = GQ[(r0 + 8 * (S8) + e) * 512 + col]; (KV)[e] = GK[(r0 + 8 * (S8) + e) * 512 + col]; } \
            _Pragma("unroll") for (int e = 0; e < 8; ++e) { const float* gd = GD + (r0 + 8 * (S8) + e) * 16; float z = bg; \
                _Pragma("unroll") for (int j = 0; j < 16; ++j) z += gd[j] * wg[j]; \
                (ZZ)[e] = z; } } while (0)
#define PREP_STEP(S8, QV, KV, ZZ) do { _Pragma("unroll") for (int e = 0; e < 8; ++e) { const int s = 8 * (S8) + e; \
                bc += log_sigmoid_fast((ZZ)[e]) * 0.0625f; \
                const float eb = __expf(bc), ieb = __builtin_amdgcn_rcpf(eb); \
                const unsigned qd = pk2(bf2f((QV)[e]) * eb, 0.f) & 0xffffu, kd = pk2(bf2f((KV)[e]) * ieb, 0.f) & 0xffffu; \
                QD[(r0 + s) * 512 + col] = (bf16)qd; Qd_l[s * 520 + col] = (bf16)qd; Kd_l[s * 520 + col] = (bf16)kd; } } while (0)
        unsigned short qa[8], ka[8], qb[8], kb[8]; float za[8], zb[8];
        PREP_LOAD(0, qa, ka, za);
#pragma unroll 1
        for (int s8 = 0; s8 < 8; s8 += 2) {
            f32x4 cpv[4];
            if (ride) RIDE_LOAD(4, cpv, cpb, s8 * 2048);
            PREP_LOAD(s8 + 1, qb, kb, zb);
            PREP_STEP(s8, qa, ka, za);
            if (ride) { RIDE_STORE(4, cpv, cpb, s8 * 2048); RIDE_LOAD(4, cpv, cpb, (s8 + 1) * 2048); }
            { const int s8n = s8 + 2 < 8 ? s8 + 2 : 7; PREP_LOAD(s8n, qa, ka, za); }
            PREP_STEP(s8 + 1, qb, kb, zb);
            if (ride) RIDE_STORE(4, cpv, cpb, (s8 + 1) * 2048);
        }
#undef PREP_STEP
#undef PREP_LOAD
        const float dec = __expf(bc);
        DEC[(size_t)cidx * 512 + col] = dec;
#pragma unroll
        for (int s8 = 0; s8 < 8; ++s8) {
            float ke[8];
#pragma unroll
            for (int e = 0; e < 8; ++e) ke[e] = bf2f(Kd_l[(8 * s8 + e) * 520 + col]) * dec;
            v4u w; w.x = pk2(ke[0], ke[1]); w.y = pk2(ke[2], ke[3]); w.z = pk2(ke[4], ke[5]); w.w = pk2(ke[6], ke[7]);
            *(v4u*)(KET + ((size_t)cidx * 512 + col) * 64 + 8 * s8) = w;
        }
        __syncthreads();
        int ln_ = F.lane; asm volatile("" : "+v"(ln_));
        const int fr = ln_ & 15, fq = ln_ >> 4;
        const int h = F.wave >> 1;
#pragma unroll
        for (int i = 0; i < 8; ++i) {
            const int sb = (F.wave & 1) * 2 + (i >> 2), tb = i & 3;
            f32x4 acc = {0.f, 0.f, 0.f, 0.f};
#pragma unroll
            for (int ks = 0; ks < 4; ++ks) {
                const bf16x8 a = *(const LAS bf16x8*)(Kd_l + (16 * sb + fr) * 520 + h * 128 + 32 * ks + 8 * fq);
                const bf16x8 bq = *(const LAS bf16x8*)(Qd_l + (16 * tb + fr) * 520 + h * 128 + 32 * ks + 8 * fq);
                acc = MFMA16(a, bq, acc);
            }
            int t = 16 * tb + fr; const int s0 = 16 * sb + 4 * fq;
            asm volatile("" : "+v"(t));
            v2u o; o.x = pk2(s0 + 0 <= t ? acc[0] : 0.f, s0 + 1 <= t ? acc[1] : 0.f); o.y = pk2(s0 + 2 <= t ? acc[2] : 0.f, s0 + 3 <= t ? acc[3] : 0.f);
            *(v2u*)(ATT + (((size_t)cidx * 4 + h) * 64 + t) * 64 + s0) = o;
        }
    }
}
__device__ __forceinline__ void gla_scan_phase(Frame& F) {
    const bf16* QD = WSP(bf16, WS_QD); const bf16* KET = WSP(bf16, WS_KET); const bf16* ATT = WSP(bf16, WS_ATT); const float* DEC = WSP(float, WS_DEC);
    const bf16* GV = WSP(bf16, WS_GV); float* GO = WSP(float, WS_GO);
    const int fr = F.lane & 15, fq = F.lane >> 4, w = F.wave, tb = w >> 1, cbo = w & 1;
    const int vcu = (F.G % 8 == 0) ? (F.bid % 8) * (F.G / 8) + F.bid / 8 : F.bid;
    for (int chain = vcu; chain < 256; chain += F.G) {
        const int b = chain >> 5, h = (chain >> 3) & 3, vs = chain & 7;
        f32x4 S[2]; S[0] = (f32x4){0.f, 0.f, 0.f, 0.f}; S[1] = (f32x4){0.f, 0.f, 0.f, 0.f};
        __syncthreads();
        bf16x8 qd[3][4], at[3][2], ke[3][2]; f32x4 dc[3]; v2u vv[3];
        const bool ride = (F.G == 256) && chain == vcu; const CpBase cb0 = copy_base(F, 768u + (unsigned)F.bid); f32x4 cpa[3];
#define SCAN_LOAD(CH, SET) do { const size_t ci_ = (size_t)b * 32 + (CH), rr_ = ci_ * 64; \
            _Pragma("unroll") for (int ks = 0; ks < 4; ++ks) qd[SET][ks] = *(const bf16x8*)(QD + (rr_ + 16 * tb + fr) * 512 + h * 128 + 32 * ks + 8 * fq); \
            _Pragma("unroll") for (int ks = 0; ks < 2; ++ks) { at[SET][ks] = *(const bf16x8*)(ATT + ((ci_ * 4 + h) * 64 + 16 * tb + fr) * 64 + 32 * ks + 8 * fq); \
                                             ke[SET][ks] = *(const bf16x8*)(KET + (ci_ * 512 + h * 128 + 16 * w + fr) * 64 + 32 * ks + 8 * fq); } \
            dc[SET] = *(const f32x4*)(DEC + ci_ * 512 + h * 128 + 16 * w + 4 * fq); \
            vv[SET] = *(const v2u*)(GV + (rr_ + (F.tid >> 3)) * 1024 + h * 256 + vs * 32 + (F.tid & 7) * 4); \
            if (ride) { const unsigned e_ = (unsigned)(CH) * 512u + (unsigned)F.tid; cpa[SET] = __builtin_nontemporal_load(cb0.src + (e_ < cb0.n ? e_ : cb0.n - 1u)); } } while (0)
#define SCAN_STEP(CH, SET) do { const size_t r0_ = ((size_t)b * 32 + (CH)) * 64; \
            LAS bf16* Vt_l = (LAS bf16*)(F.lds + RING_OFF + ((CH) & 1) * 16384);              \
            LAS bf16* St_l = (LAS bf16*)(F.lds + RING_OFF + ((CH) & 1) * 16384 + 4608);       \
            { const int s_ = F.tid >> 3, c4 = (F.tid & 7) * 4; const v2u v_ = vv[SET]; \
              Vt_l[(c4 + 0) * 72 + s_] = (bf16)(v_.x & 0xffffu); Vt_l[(c4 + 1) * 72 + s_] = (bf16)(v_.x >> 16); Vt_l[(c4 + 2) * 72 + s_] = (bf16)(v_.y & 0xffffu); Vt_l[(c4 + 3) * 72 + s_] = (bf16)(v_.y >> 16); } \
            _Pragma("unroll") for (int cb = 0; cb < 2; ++cb) { v2u sv; sv.x = pk2(S[cb][0], S[cb][1]); sv.y = pk2(S[cb][2], S[cb][3]); *(LAS v2u*)(St_l + (16 * cb + fr) * 136 + 16 * w + 4 * fq) = sv; } \
            LDS_BARRIER(); \
            f32x4 o = {0.f, 0.f, 0.f, 0.f}; \
            _Pragma("unroll") for (int ks = 0; ks < 4; ++ks) { const bf16x8 bs = *(const LAS bf16x8*)(St_l + (16 * cbo + fr) * 136 + 32 * ks + 8 * fq); o = MFMA16(qd[SET][ks], bs, o); } \
            _Pragma("unroll") for (int ks = 0; ks < 2; ++ks) { const bf16x8 bv = *(const LAS bf16x8*)(Vt_l + (16 * cbo + fr) * 72 + 32 * ks + 8 * fq); o = MFMA16(at[SET][ks], bv, o); } \
            _Pragma("unroll") for (int cb = 0; cb < 2; ++cb) { S[cb] = S[cb] * dc[SET]; \
                _Pragma("unroll") for (int ks = 0; ks < 2; ++ks) { const bf16x8 bv = *(const LAS bf16x8*)(Vt_l + (16 * cb + fr) * 72 + 32 * ks + 8 * fq); S[cb] = MFMA16(ke[SET][ks], bv, S[cb]); } } \
            _Pragma("unroll") for (int j = 0; j < 4; ++j) GO[(r0_ + 16 * tb + 4 * fq + j) * 1024 + h * 256 + vs * 32 + 16 * cbo + fr] = o[j]; \
            if (ride) { const unsigned e_ = (unsigned)(CH) * 512u + (unsigned)F.tid; if (e_ < cb0.n) __builtin_nontemporal_store(cpa[SET], cb0.dst + e_); } } while (0)
        SCAN_LOAD(0, 0); SCAN_LOAD(1, 1);
#pragma unroll 1
        for (int ch = 0; ch < 30; ch += 3) {
            SCAN_LOAD(ch + 2, 2);      SCAN_STEP(ch, 0);
            SCAN_LOAD(ch + 3, 0);      SCAN_STEP(ch + 1, 1);
            SCAN_LOAD(ch + 4, 1);      SCAN_STEP(ch + 2, 2);
        }
        SCAN_STEP(30, 0); SCAN_STEP(31, 1);
#undef SCAN_LOAD
#undef SCAN_STEP
        float* so = F_OUT + O_GLAP + ((size_t)(b * 4 + h) * 128) * 256 + vs * 32;
#pragma unroll
        for (int cb = 0; cb < 2; ++cb)
#pragma unroll
            for (int j = 0; j < 4; ++j) so[(size_t)(16 * w + 4 * fq + j) * 256 + 16 * cb + fr] = S[cb][j];
    }
}
__device__ __forceinline__ void gla_sample_phase(Frame& F) {
    LAS float* qd_l = (LAS float*)(F.lds + RING_OFF);
    LAS float* ke_l = qd_l + 512;
    LAS float* dec_l = ke_l + 512;
    LAS float* v_l = dec_l + 128;
    LAS float* aw_l = v_l + 1024;
    LAS float* op_l = aw_l + 32;
    const bf16* GQ = WSP(bf16, WS_GQ); const bf16* GK = WSP(bf16, WS_GK); const bf16* GV = WSP(bf16, WS_GV); const float* GD = WSP(float, WS_GD);
    float* GO = WSP(float, WS_GO);
    for (int uidx = F.bid; uidx < NBS * 4; uidx += F.G) {
        const int b = uidx >> 2, h = uidx & 3; const size_t rs0 = (size_t)MP + 4 * b;
        __syncthreads();
        if (F.tid < 128) {
            const int k = F.tid, col = h * 128 + k;
            float bt[4], qv[4], kv[4]; float bc = 0.f;
#pragma unroll
            for (int t = 0; t < 4; ++t) {
                float z = F.inp(21)[col];
#pragma unroll
                for (int j = 0; j < 16; ++j) z += GD[(rs0 + t) * 16 + j] * F.inp(20)[j * 512 + col];
                bc += log_sigmoid(z) * 0.0625f; bt[t] = bc;
                qv[t] = bf2f(GQ[(rs0 + t) * 512 + col]); kv[t] = bf2f(GK[(rs0 + t) * 512 + col]);
            }
#pragma unroll
            for (int t = 0; t < 4; ++t) { qd_l[t * 128 + k] = qv[t] * __expf(bt[t]); ke_l[t * 128 + k] = kv[t] * __expf(bt[3] - bt[t]); }
            dec_l[k] = __expf(bt[3]);
            int p = 0;
#pragma unroll
            for (int t = 0; t < 4; ++t)
#pragma unroll
                for (int s = 0; s <= t; ++s) { const float term = wave_sum(qv[t] * kv[s] * __expf(bt[t] - bt[s])); if (F.lane == 0) aw_l[F.wave * 16 + p] = term; ++p; }
        } else {
            for (int i = F.tid - 128; i < 1024; i += 384) { const int t = i >> 8, c = i & 255; v_l[i] = bf2f(GV[(rs0 + t) * 1024 + h * 256 + c]); }
        }
        __syncthreads();
        const int v4 = (F.tid & 63) * 4, kg = F.tid >> 6;
        const float* S0 = F.inp(6) + ((size_t)(b * 4 + h) * 128) * 256 + v4;
        float* Sf = F_OUT + O_GLAS + ((size_t)(b * 4 + h) * 128) * 256 + v4;
        const f32x4 v0 = *(const LAS f32x4*)(v_l + v4), v1 = *(const LAS f32x4*)(v_l + 256 + v4), v2 = *(const LAS f32x4*)(v_l + 512 + v4), v3 = *(const LAS f32x4*)(v_l + 768 + v4);
        f32x4 o0 = {0.f, 0.f, 0.f, 0.f}, o1 = o0, o2 = o0, o3 = o0;
        f32x4 sv[16];
#pragma unroll
        for (int kk = 0; kk < 16; ++kk) sv[kk] = __builtin_nontemporal_load((const f32x4*)(S0 + (size_t)(16 * kg + kk) * 256));
#pragma unroll
        for (int kk = 0; kk < 16; ++kk) {
            const int k = 16 * kg + kk; const f32x4 s0 = sv[kk];
            o0 += s0 * qd_l[k]; o1 += s0 * qd_l[128 + k]; o2 += s0 * qd_l[256 + k]; o3 += s0 * qd_l[384 + k];
            const f32x4 sf = s0 * dec_l[k] + ((v0 * ke_l[k] + v1 * ke_l[128 + k]) + (v2 * ke_l[256 + k] + v3 * ke_l[384 + k]));
            __builtin_nontemporal_store(sf, (f32x4*)(Sf + (size_t)k * 256));
        }
        *(LAS f32x4*)(op_l + (kg * 4 + 0) * 256 + v4) = o0; *(LAS f32x4*)(op_l + (kg * 4 + 1) * 256 + v4) = o1;
        *(LAS f32x4*)(op_l + (kg * 4 + 2) * 256 + v4) = o2; *(LAS f32x4*)(op_l + (kg * 4 + 3) * 256 + v4) = o3;
        __syncthreads();
        {
            const int t = F.tid >> 7, c = (F.tid & 127) * 2;
            f32x2 r = {0.f, 0.f};
#pragma unroll
            for (int q = 0; q < 8; ++q) r += *(const LAS f32x2*)(op_l + (q * 4 + t) * 256 + c);
            const int p0 = (t * (t + 1)) >> 1;
            for (int s = 0; s <= t; ++s) { const float a = aw_l[p0 + s] + aw_l[16 + p0 + s]; r += *(const LAS f32x2*)(v_l + s * 256 + c) * a; }
            *(f32x2*)(GO + (rs0 + t) * 1024 + h * 256 + c) = r;
        }
    }
}
__device__ __forceinline__ void gla_post_phase(Frame& F) {
    const float* GO = WSP(float, WS_GO); const bf16* GR = WSP(bf16, WS_GR); bf16* GA = WSP(bf16, WS_GA);
    const int nw = F.G * NWAVES;
    for (int idx0 = F.bid * NWAVES + F.wave; idx0 < M * 4; idx0 += 8 * nw) {
        f32x4 o[8]; v2u rw[8];
#pragma unroll
        for (int u = 0; u < 8; ++u) { const int idx = idx0 + u * nw < M * 4 ? idx0 + u * nw : idx0; const size_t off = (size_t)(idx >> 2) * 1024 + (idx & 3) * 256 + 4 * F.lane;
            o[u] = *(const f32x4*)(GO + off); rw[u] = *(const v2u*)(GR + off); }
#pragma unroll
        for (int u = 0; u < 8; ++u) { const int idx = idx0 + u * nw; if (idx < M * 4) { const size_t off = (size_t)(idx >> 2) * 1024 + (idx & 3) * 256 + 4 * F.lane;
            const float ss = wave_sum((o[u][0] * o[u][0] + o[u][1] * o[u][1]) + (o[u][2] * o[u][2] + o[u][3] * o[u][3]));
            const float rinv = __builtin_amdgcn_rsqf(ss * (1.0f / 256.0f) + EPS);
            const f32x4 gn = *(const f32x4*)(F.inp(22) + (idx & 3) * 256 + 4 * F.lane);
            const float r[4] = {bflo(rw[u].x), bfhi(rw[u].x), bflo(rw[u].y), bfhi(rw[u].y)};
            float y[4];
#pragma unroll
            for (int j = 0; j < 4; ++j) y[j] = (o[u][j] * rinv * gn[j]) * (r[j] / (1.0f + __expf(-r[j])));
            v2u w; w.x = pk2(y[0], y[1]); w.y = pk2(y[2], y[3]); *(v2u*)(GA + off) = w; } }
    }
}
__device__ __forceinline__ void final_norm_phase(Frame& F, int first_row) {
    const int nw = F.G * NWAVES;
    for (int row0 = first_row + F.bid * NWAVES + F.wave; row0 < M; row0 += 2 * nw) {
        f32x4 v[2][4];
#pragma unroll
        for (int u = 0; u < 2; ++u) { const int row = row0 + u * nw < M ? row0 + u * nw : row0; const float* xr = F_OUT + O_Y + (size_t)row * D;
#pragma unroll
            for (int j = 0; j < 4; ++j) v[u][j] = *(const f32x4*)(xr + 4 * F.lane + 256 * j); }
#pragma unroll
        for (int u = 0; u < 2; ++u) { const int row = row0 + u * nw; if (row < M) { float* xr = F_OUT + O_Y + (size_t)row * D; float s = 0.f;
#pragma unroll
            for (int j = 0; j < 4; ++j) s += (v[u][j][0] * v[u][j][0] + v[u][j][1] * v[u][j][1]) + (v[u][j][2] * v[u][j][2] + v[u][j][3] * v[u][j][3]);
            const float rinv = __builtin_amdgcn_rsqf(wave_sum(s) * (1.0f / D) + EPS);
#pragma unroll
            for (int j = 0; j < 4; ++j) { const f32x4 gn = *(const f32x4*)(F.inp(13) + 4 * F.lane + 256 * j); *(f32x4*)(xr + 4 * F.lane + 256 * j) = v[u][j] * rinv * gn; } } }
    }
}
#ifndef REP_MASK
#define REP_MASK 0
#endif
#define NREP(k) (1 + ((REP_MASK >> (k)) & 1))
#ifndef PH_MASK
#define PH_MASK 0xFFFF
#endif
#define EN_P0 ((PH_MASK >> 0) & 1)
#define EN_MOD ((PH_MASK >> 1) & 1)
#define EN_CB ((PH_MASK >> 2) & 1)
#define EN_POOL ((PH_MASK >> 3) & 1)
#define EN_QKV ((PH_MASK >> 4) & 1)
#define EN_ATTN ((PH_MASK >> 5) & 1)
#define EN_MERGE ((PH_MASK >> 6) & 1)
#define EN_GLAIN ((PH_MASK >> 7) & 1)
#define EN_PREP ((PH_MASK >> 8) & 1)
#define EN_SCAN ((PH_MASK >> 9) & 1)
#define EN_POST ((PH_MASK >> 10) & 1)
#define EN_MIX ((PH_MASK >> 11) & 1)
#define EN_FFNIN ((PH_MASK >> 12) & 1)
#define EN_FIX ((PH_MASK >> 13) & 1)
#define EN_FFND ((PH_MASK >> 14) & 1)
#define EN_FINAL ((PH_MASK >> 15) & 1)

struct CbOrder {
    int G, c;
    __device__ bool next(int i, pg8::Unit& u) const { const int L = i * G + c; if (L >= 110) return false; u.pn = L; u.pm = L < 88 ? L / 22 : (L < 97 ? 4 : 5); return true; }
    __device__ __forceinline__ void a_ready(const pg8::Unit&) const {}
    __device__ __forceinline__ void done(const pg8::Unit&) const {}
};
constexpr int NPH = 27;
struct Args { const float* in[28]; float* out; unsigned char* ws; int ph_lo, ph_hi; };
__global__ void __launch_bounds__(NWAVES * 64, 2) hybrid_fwd(Args args) {
    extern __shared__ __attribute__((aligned(16))) unsigned char lds[];
    Frame F;
    F.lds = (LAS unsigned char*)lds;
    F.tid = threadIdx.x; F.lane = F.tid & 63; F.wave = __builtin_amdgcn_readfirstlane(F.tid >> 6);
    F.G = gridDim.x; F.bid = blockIdx.x;
    F.ka = (const __attribute__((address_space(4))) unsigned char*)__builtin_amdgcn_kernarg_segment_ptr();
    F.out_g = (GAS float*)args.out; F.ws_g = (GAS unsigned char*)args.ws;
    for (int u = F.tid; u < (LDS_BYTES - LDSCTL_OFF) / 4; u += NWAVES * 64) ((LAS unsigned*)(F.lds + LDSCTL_OFF))[u] = 0u;
    __syncthreads();
    const int lo = args.ph_lo, hi = args.ph_hi;
    XcdBarrier bar; bar.bar = (unsigned*)(F_WS + WS_CTL) + CW_BAR; bar.x = 0; bar.st = nullptr;
    if (hi - lo > 1) bar = xcd_barrier_post((unsigned*)(F_WS + WS_CTL) + CW_BAR, (volatile LAS unsigned*)(F.lds + MISC_OFF) + 8, F.tid);
    int ph = 0;
#define RELAUNDER() do { asm volatile("" : "+s"(F.wave)); F.lane = fresh_lane(); F.tid = F.wave * 64 + F.lane; asm volatile("" : "+s"(F.ws_g), "+s"(F.out_g), "+s"(F.ka), "+s"(F.G), "+s"(F.bid)); } while (0)
#define IN() (lo <= ph && ph < hi)
#define REPBAR(r) (((r) > 0 && hi - lo > 1) ? (xcd_barrier(bar, F.tid), true) : true)
#define SEAM() do { if (lo <= ph && ph + 1 < hi) xcd_barrier(bar, F.tid); ++ph; RELAUNDER(); } while (0)
#define X (F_OUT + O_Y)
#define xs_in (F.inp(1) - (size_t)MP * D)
#define MOD WSP(float, WS_MOD)
#define RS0 WSP(float, WS_RSS)
#define RS1 (WSP(float, WS_RSS) + 262144)
#define ZERO_ROWSUMS(p) do { for (int i_ = F.bid * 512 + F.tid; i_ < M; i_ += F.G * 512) (p)[i_] = 0.f; } while (0)
#define CB WSP(float, WS_CB)
#define AN WSP(bf16, WS_AN)

    for (int rep_ = 0; rep_ < NREP(0); ++rep_) if (EN_P0 && IN() && REPBAR(rep_)) { p0_prologue(F); ZERO_ROWSUMS(RS0); ZERO_ROWSUMS(RS1); __syncthreads(); mod_direct_phase(F); }
    SEAM();
    for (int l = 0; l < 4; ++l) {
        const int kind = l % 3, jl = l / 3;
        if (kind == 0) {
            for (int rep_ = 0; rep_ < NREP(3); ++rep_) if (EN_POOL && IN() && REPBAR(rep_)) {
                if (EN_CB && l == 0) {
                    pg8::Gemm g{WSP(bf16, WS_SH), WSP(bf16, WS_WNF), 1024, 1024, 1024, 0}; CbOrder S{F.G, F.bid};
                    pg8::EpiCb E{CB};
                    pg8::gemm_phase<pg8::EpiCb, CbOrder, true, true>(F.lds + RING_OFF, g, S, E, F.wave);
                    __syncthreads();
                }
                pool_diff_phase(F, l, jl, (l == 0) ? F.inp(0) : X, (l == 0) ? xs_in : X, (l == 0) ? nullptr : RS1, EN_CB && l == 0 && F.G == 256);
            }
            SEAM();
        } else if (kind == 1) {
            for (int rep_ = 0; rep_ < NREP(4); ++rep_) if (EN_QKV && IN() && REPBAR(rep_)) {
                pg8::Gemm g{AN, WSP(bf16, WS_WNF) + (size_t)22528 * 1024, 1024, 1024, 1024, 0}; pg8::StaticOrder S; S.init(M, 2304, F.G, F.bid);
                pg8::EpiQkv E{RS1, CB + (size_t)4 * 256 * 5632, WSP(bf16, WS_QB), F_OUT, pg8::EpiRide{F.inp(5), F_OUT + O_W3S, 1332, (F.G == 256 && !rep_) ? 592 : 0}};
                pg8::gemm_phase<pg8::EpiQkv, pg8::StaticOrder, true, true>(F.lds + RING_OFF, g, S, E, F.wave);
                { const int nwg_ = 66 * 9, maxu_ = (nwg_ + F.G - 1) / F.G, myu_ = (nwg_ - F.bid + F.G - 1) / F.G; if (!rep_ && myu_ < maxu_) copy_pull(F, 2); }
            }
            SEAM();
            for (int rep_ = 0; rep_ < NREP(5); ++rep_) if (EN_ATTN && IN() && REPBAR(rep_)) attn_phase(F);
            SEAM();
            for (int rep_ = 0; rep_ < NREP(6); ++rep_) if (EN_MERGE && IN() && REPBAR(rep_)) attn_merge_phase(F);
            SEAM();
        } else {
            for (int rep_ = 0; rep_ < NREP(7); ++rep_) if (EN_GLAIN && IN() && REPBAR(rep_)) {
                pg8::Gemm g{AN, WSP(bf16, WS_WNF) + (size_t)24832 * 1024, 1024, 1024, 1024, 0}; pg8::StaticOrder S; S.init(M, 3328, F.G, F.bid);
                pg8::EpiGlaIn E{RS1, CB + (size_t)4 * 256 * 5632 + (size_t)256 * 2304, WSP(bf16, WS_GQ), WSP(float, WS_GD), pg8::EpiRide{F.inp(5), F_OUT + O_W3S, 1406, (F.G == 256 && !rep_) ? 856 : 0}};
                pg8::gemm_phase<pg8::EpiGlaIn, pg8::StaticOrder, true, true>(F.lds + RING_OFF, g, S, E, F.wave);
                { const int nwg_ = 66 * 13, maxu_ = (nwg_ + F.G - 1) / F.G, myu_ = (nwg_ - F.bid + F.G - 1) / F.G; if (!rep_ && myu_ < maxu_) copy_pull(F, 2); }
            }
            SEAM();
            for (int rep_ = 0; rep_ < NREP(8); ++rep_) if (EN_PREP && IN() && REPBAR(rep_)) { gla_prep_phase(F); gla_sample_phase(F); }
            SEAM();
            for (int rep_ = 0; rep_ < NREP(9); ++rep_) if (EN_SCAN && IN() && REPBAR(rep_)) gla_scan_phase(F);
            SEAM();
            for (int rep_ = 0; rep_ < NREP(10); ++rep_) if (EN_POST && IN() && REPBAR(rep_)) gla_post_phase(F);
            SEAM();
        }
        for (int rep_ = 0; rep_ < NREP(11); ++rep_) if (EN_MIX && IN() && REPBAR(rep_)) {
            pg8::StaticOrder S; S.init(MP, 1024, F.G, F.bid);
            const pg8::Gemm gm = kind == 0 ? pg8::Gemm{WSP(bf16, WS_DP), WSP(bf16, WS_WP) + (size_t)jl * 1024 * 256, 1024, 256, 256, 256}
                               : (kind == 1 ? pg8::Gemm{WSP(bf16, WS_AO), WSP(bf16, WS_WAO), 768, 768, 768, 0} : pg8::Gemm{WSP(bf16, WS_GA), WSP(bf16, WS_WGO), 1024, 1024, 1024, 0});
            pg8::EpiRes E{(l == 0) ? F.inp(0) : X, (l == 0) ? xs_in : X, rep_ ? WSP(float, WS_DUMMY) : X, MOD + l * 6144 + 2 * 1024, kind == 0 ? F.inp(16) + (size_t)jl * D : nullptr,
                          F.inp(12) + (size_t)(l * 2 + 1) * D, MOD + l * 6144 + 4 * 1024, rep_ ? WSP(bf16, WS_DUMMY2) : AN, rep_ ? WSP(float, WS_DUMMY3) : RS0, nullptr, nullptr};
            if (!rep_) ZERO_ROWSUMS(RS1);
            pg8::gemm_phase<pg8::EpiRes, pg8::StaticOrder, true, true>(F.lds + RING_OFF, gm, S, E, F.wave);
            rider_res(F, gm, E);
        }
        SEAM();
        for (int rep_ = 0; rep_ < NREP(12); ++rep_) if (EN_FFNIN && IN() && REPBAR(rep_)) {
            pg8::Gemm g{AN, WSP(bf16, WS_WNF) + (size_t)l * 5632 * 1024, 1024, 1024, 1024, 0}; pg8::StaticOrder S; S.init(M, 5632, F.G, F.bid);
            pg8::EpiFfnIn E{RS0, CB + (size_t)l * 256 * 5632, F.inp(25) + (size_t)l * 3 * DFF, F.inp(26) + (size_t)l * DFF, F.inp(7) + (size_t)l * NBS * 2 * DFF,
                            WSP(bf16, WS_ACT), WSP(float, WS_HG), WSP(float, WS_HU), WSP(float, WS_TG), F_OUT + O_CONVP + (size_t)l * NBP * 2 * DFF, F_OUT + O_CONVS + (size_t)l * NBS * 2 * DFF,
                            pg8::EpiRide{F.inp(5), F_OUT + O_W3S, 1152 + 45 * l, (F.G == 256 && !rep_) ? 1440 : 0}};
            pg8::gemm_phase<pg8::EpiFfnIn, pg8::StaticOrder, true, true>(F.lds + RING_OFF, g, S, E, F.wave);
                { const int nwg_ = 66 * 22, maxu_ = (nwg_ + F.G - 1) / F.G, myu_ = (nwg_ - F.bid + F.G - 1) / F.G; if (!rep_ && myu_ < maxu_) copy_pull(F, 2); }
        }
        SEAM();
        for (int rep_ = 0; rep_ < NREP(13); ++rep_) if (EN_FIX && IN() && REPBAR(rep_)) ffn_fixup_phase(F, l);
        SEAM();
        for (int rep_ = 0; rep_ < NREP(14); ++rep_) if (EN_FFND && IN() && REPBAR(rep_)) {
            pg8::Gemm g{WSP(bf16, WS_ACT), WSP(bf16, WS_WD) + (size_t)l * 1024 * DFF, DFF, DFF, DFF, 0}; pg8::StaticOrder S; S.init(MP, 1024, F.G, F.bid);
            pg8::EpiRes E{X, X, rep_ ? WSP(float, WS_DUMMY) : X, MOD + l * 6144 + 5 * 1024, nullptr,
                          (l < 3 && (l + 1) % 3 != 0) ? F.inp(12) + (size_t)((l + 1) * 2) * D : nullptr, MOD + (l + 1) * 6144 + 1 * 1024, rep_ ? WSP(bf16, WS_DUMMY2) : AN, rep_ ? WSP(float, WS_DUMMY3) : RS1,
                          (l == 3 && !rep_ && F.G == 256) ? F.inp(13) : nullptr, (unsigned*)(F_WS + WS_CTL) + CW_FINCNT};
            if (!rep_) ZERO_ROWSUMS(RS0);
            pg8::gemm_phase<pg8::EpiRes, pg8::StaticOrder, true, true>(F.lds + RING_OFF, g, S, E, F.wave);
            rider_res(F, g, E);
        }
        SEAM();
    }
    for (int rep_ = 0; rep_ < NREP(15); ++rep_) if (EN_FINAL && IN() && REPBAR(rep_)) { final_norm_phase(F, F.G == 256 ? MP : 0); copy_pull(F, 0); }
#undef X
#undef xs_in
#undef MOD
#undef RS0
#undef RS1
#undef CB
#undef AN
#undef IN
#undef SEAM
}

extern "C" void kernel_launch(void* const* d_in, const int* in_sizes, int n_in, void* d_out, int out_size, void* d_ws, size_t ws_size, hipStream_t stream) {
    static int grid = 0;
    if (grid == 0) {
        if (n_in != 28 || (size_t)out_size != O_END || ws_size < WS_END) { fprintf(stderr, "kernel_launch: unexpected shapes: n_in %d out %d (want %zu) ws %zu (want %zu)\n", n_in, out_size, (size_t)O_END, ws_size, (size_t)WS_END); grid = -1; return; }
        int dev = 0, cus = 0, per_cu = 0;
        if (hipGetDevice(&dev) != hipSuccess || hipDeviceGetAttribute(&cus, hipDeviceAttributeMultiprocessorCount, dev) != hipSuccess) { fprintf(stderr, "kernel_launch: device query failed\n"); grid = -1; return; }
        if (hipFuncSetAttribute((const void*)hybrid_fwd, hipFuncAttributeMaxDynamicSharedMemorySize, LDS_BYTES) != hipSuccess) { fprintf(stderr, "kernel_launch: hipFuncSetAttribute failed\n"); grid = -1; return; }
        if (hipOccupancyMaxActiveBlocksPerMultiprocessor(&per_cu, (const void*)hybrid_fwd, NWAVES * 64, LDS_BYTES) != hipSuccess || per_cu < 1)
            fprintf(stderr, "kernel_launch: note: occupancy query reports %d workgroups per CU\n", per_cu);
        (void)hipGetLastError();
        grid = cus;
    }
    if (grid < 0) return;
    if (hipMemsetAsync((char*)d_ws + WS_CTL, 0, CTL_ZERO_BYTES, stream) != hipSuccess) { fprintf(stderr, "kernel_launch: memset failed\n"); return; }
    Args a{};
    for (int i = 0; i < 28; ++i) a.in[i] = (const float*)d_in[i];
    a.out = (float*)d_out; a.ws = (unsigned char*)d_ws;
#if MK_LAUNCH_PER_PHASE
    for (int p = 0; p < NPH; ++p) { a.ph_lo = p; a.ph_hi = p + 1; hipLaunchKernelGGL(hybrid_fwd, dim3(grid), dim3(NWAVES * 64), LDS_BYTES, stream, a); }
#else
    a.ph_lo = 0; a.ph_hi = NPH; hipLaunchKernelGGL(hybrid_fwd, dim3(grid), dim3(NWAVES * 64), LDS_BYTES, stream, a);
#endif
    const hipError_t le = hipPeekAtLastError();
    if (le != hipSuccess) fprintf(stderr, "kernel_launch: launch failed: %s\n", hipGetErrorName(le));
}
```

```cpp
#include <hip/hip_runtime.h>
#include <cstdio>
#include <cstdint>

#ifndef MK_LAUNCH_PER_PHASE
#define MK_LAUNCH_PER_PHASE 0
#endif

constexpr int D = 1024, MP = 16384, MS = 512, M = MP + MS, TP = 2048, NBP = 8, NBS = 128, DFF = 2816, NBI = 136;
constexpr int MODLD = 24576;
constexpr int NWNF = 28160;
constexpr float EPS = 1e-6f;

#define GAS __attribute__((address_space(1)))
#define LAS __attribute__((address_space(3)))
typedef unsigned short bf16;
typedef unsigned v4u __attribute__((ext_vector_type(4)));
typedef unsigned v2u __attribute__((ext_vector_type(2)));
typedef float f32x4 __attribute__((ext_vector_type(4)));
typedef float f32x2 __attribute__((ext_vector_type(2)));
typedef short bf16x8 __attribute__((ext_vector_type(8)));
typedef __bf16 hbf2 __attribute__((ext_vector_type(2)));
#define LDS_WAIT() asm volatile("s_waitcnt lgkmcnt(0)" ::: "memory")
#define VM_WAIT() asm volatile("s_waitcnt vmcnt(0)" ::: "memory")
__device__ __forceinline__ unsigned pk2(float lo, float hi) { f32x2 v = {lo, hi}; return __builtin_bit_cast(unsigned, __builtin_convertvector(v, hbf2)); }
__device__ __forceinline__ float bf2f(unsigned short b) { return __builtin_bit_cast(float, ((unsigned)b) << 16); }
__device__ __forceinline__ float bflo(unsigned w) { return __builtin_bit_cast(float, w << 16); }
__device__ __forceinline__ float bfhi(unsigned w) { return __builtin_bit_cast(float, w & 0xffff0000u); }
__device__ __forceinline__ float wave_sum(float v) {
#pragma unroll
    for (int o = 1; o < 64; o <<= 1) v += __shfl_xor(v, o);
    return v;
}
__device__ __forceinline__ int batch_of_row(int r) { return r < MP ? (r >> 11) : NBP + ((r - MP) >> 2); }

__device__ __forceinline__ int fresh_lane() { int l = (int)__builtin_amdgcn_mbcnt_hi(~0u, __builtin_amdgcn_mbcnt_lo(~0u, 0u)); asm volatile("" : "+v"(l)); return l; }
#define MFMA16(a, b, c) __builtin_amdgcn_mfma_f32_16x16x32_bf16((a), (b), (c), 0, 0, 0)
#define LDS_BARRIER() do { asm volatile("s_waitcnt lgkmcnt(0)" ::: "memory"); __builtin_amdgcn_s_barrier(); asm volatile("" ::: "memory"); } while (0)

constexpr size_t MiB = 1u << 20;
constexpr size_t WS_CTL = 0, CTL_ZERO_BYTES = 1 * MiB;
constexpr size_t WS_WNF  = 1 * MiB;
constexpr size_t WS_WD   = WS_WNF + 56 * MiB;
constexpr size_t WS_WAO  = WS_WD + 23 * MiB;
constexpr size_t WS_WGO  = WS_WAO + 2 * MiB;
constexpr size_t WS_WP   = WS_WGO + 2 * MiB;
constexpr size_t WS_WADA = WS_WP + 1 * MiB;
constexpr size_t WS_SC   = WS_WADA + 48 * MiB;
constexpr size_t WS_SH   = WS_SC + 1 * MiB;
constexpr size_t WS_MOD  = WS_SH + 3 * MiB;
constexpr size_t WS_CB   = WS_MOD + 13 * MiB;
constexpr size_t WS_AN   = WS_CB + 28 * MiB;
constexpr size_t WS_DP   = WS_AN + 33 * MiB;
constexpr size_t WS_ACT  = WS_DP + 33 * MiB;
constexpr size_t WS_HG   = WS_ACT + 91 * MiB;
constexpr size_t WS_HU   = WS_HG + 6 * MiB;
constexpr size_t WS_TG   = WS_HU + 6 * MiB;
constexpr size_t WS_RSS  = WS_TG + 6 * MiB;
constexpr size_t WS_QB   = WS_RSS + 2 * MiB;
constexpr size_t WS_KB   = WS_QB + 25 * MiB;
constexpr size_t WS_VB   = WS_KB + 25 * MiB;
constexpr size_t WS_AO   = WS_VB + 25 * MiB;
constexpr size_t WS_LSE  = WS_AO + 25 * MiB;
constexpr size_t WS_GQ   = WS_LSE + 1 * MiB;
constexpr size_t WS_GK   = WS_GQ + 17 * MiB;
constexpr size_t WS_QD   = WS_GK + 17 * MiB;
constexpr size_t WS_KET  = WS_QD + 17 * MiB;
constexpr size_t WS_ATT  = WS_KET + 16 * MiB;
constexpr size_t WS_DEC  = WS_ATT + 8 * MiB;
constexpr size_t WS_GV   = WS_DEC + 1 * MiB;
constexpr size_t WS_GR   = WS_GV + 33 * MiB;
constexpr size_t WS_GD   = WS_GR + 33 * MiB;
constexpr size_t WS_GO   = WS_GD + 2 * MiB;
constexpr size_t WS_GA   = WS_GO + 66 * MiB;
constexpr size_t WS_DUMMY = WS_GA + 33 * MiB;
constexpr size_t WS_DUMMY2 = WS_DUMMY + 66 * MiB;
constexpr size_t WS_DUMMY3 = WS_DUMMY2 + 33 * MiB;
constexpr size_t WS_END  = WS_DUMMY3 + 2 * MiB;
constexpr int CW_BAR = 4096;
constexpr int CW_FINCNT = 16384;

constexpr size_t O_Y     = 0;
constexpr size_t O_POOLP = O_Y + (size_t)M * D;
constexpr size_t O_POOLS = O_POOLP + (size_t)2 * 8 * 15 * D;
constexpr size_t O_W1P   = O_POOLS + (size_t)2 * 128 * 15 * D;
constexpr size_t O_W1S   = O_W1P + (size_t)8 * 128 * 512;
constexpr size_t O_W2P   = O_W1S + (size_t)128 * 128 * 512;
constexpr size_t O_W2S   = O_W2P + (size_t)8 * 512 * 512;
constexpr size_t O_W3P   = O_W2S + (size_t)128 * 512 * 512;
constexpr size_t O_W3S   = O_W3P + (size_t)8 * 2048 * 512;
constexpr size_t O_GLAP  = O_W3S + (size_t)128 * 2048 * 512;
constexpr size_t O_GLAS  = O_GLAP + (size_t)8 * 4 * 128 * 256;
constexpr size_t O_CONVP = O_GLAS + (size_t)128 * 4 * 128 * 256;
constexpr size_t O_CONVS = O_CONVP + (size_t)4 * 8 * 2 * DFF;
constexpr size_t O_END   = O_CONVS + (size_t)4 * 128 * 2 * DFF;

namespace pg8 {
#define PG8_LAS __attribute__((address_space(3)))
typedef unsigned short bf16_t;
typedef short bf16x8 __attribute__((ext_vector_type(8)));
typedef float f32x4 __attribute__((ext_vector_type(4)));
typedef unsigned u32x4 __attribute__((ext_vector_type(4)));
constexpr int BM = 256, BK = 64, HALF = 128, HTB = HALF * BK * 2  , STAGE_BYTES = 8 * HTB, NXCD = 8, WGM = 8;

__host__ __device__ __forceinline__ int lds_byte(int r, int c) { const int st = (r >> 4) * 2 + (c >> 5), rr = r & 15, cc = c & 31, ob = rr * 64 + cc * 2; return st * 1024 + (ob ^ (((ob >> 9) & 1) << 5)); }
__host__ __device__ __forceinline__ void stage_rc(int b, int& R, int& C) { const int st = b / 1024, sb = b % 1024, swz = sb ^ (((sb >> 9) & 1) << 5); R = (st >> 1) * 16 + swz / 64; C = (st & 1) * 32 + (swz % 64) / 2; }
__host__ __device__ __forceinline__ int perm32(int rho) { const int n = rho >> 4, i = rho & 15; return 8 * (i >> 2) + 4 * n + (i & 3); }

struct Unit { int pm, pn; };
struct Gemm { const bf16_t* A; const bf16_t* Bt; int lda, ldb, K, a_pn; };

struct StaticOrder {
    int nM, nN, nwg, G, c;
    __host__ __device__ __forceinline__ void init(int M_, int N_, int G_, int c_) { nM = M_ / BM; nN = N_ / BM; nwg = nM * nN; G = G_; c = c_; }
    __host__ __device__ __forceinline__ bool next(int i, Unit& u) const {
        const long L = (long)i * G + c; if (L >= nwg) return false;
        int wgid = (int)L; { const int q = nwg / NXCD, r = nwg % NXCD, xcd = wgid % NXCD, off = wgid / NXCD; wgid = (xcd < r ? xcd * (q + 1) : r * (q + 1) + (xcd - r) * q) + off; }
        const int nig = WGM * nN, gid = wgid / nig, fm = gid * WGM, gsz = (nM - fm) < WGM ? (nM - fm) : WGM;
        u.pm = fm + ((wgid % nig) % gsz); u.pn = (wgid % nig) / gsz; return true;
    }
    __device__ __forceinline__ void a_ready(const Unit&) const {}
    __device__ __forceinline__ void done(const Unit&) const {}
};

template <class Epi, class Sched, bool ALIGN_EPI = false, bool SP2 = false>
__device__ __forceinline__ void gemm_phase(PG8_LAS unsigned char* lds, const Gemm g, const Sched& S, const Epi& E, int wave_id  ) {
    const int lane = fresh_lane(), wid = wave_id, tid = wid * 64 + lane, wr = wid >> 2, wc = wid & 3, fr = lane & 15, fq = lane >> 4;
    const int K = g.K, nt = K / BK;
    unsigned voffA[2], voffB[2];
#pragma unroll
    for (int i = 0; i < 2; ++i) { int R, C; stage_rc(tid * 16 + i * 8192, R, C); const int Rb = Epi::PERM ? ((R & ~31) + perm32(R & 31)) : R;
        voffA[i] = (unsigned)(R * g.lda + C) * 2u; voffB[i] = (unsigned)(Rb * g.ldb + C) * 2u; }
    const size_t kstep = (size_t)(BK * 2);
    const size_t hstepA = (size_t)HALF * g.lda * 2, hstepB = (size_t)HALF * g.ldb * 2;
    const size_t tstepA = 2 * hstepA, tstepB = 2 * hstepB, pnA = (size_t)g.a_pn * 2;
    const unsigned ldsw = (unsigned)wid * 1024u;
    const int aoff = lds_byte(wr * 64 + fr, fq * 8), boff = lds_byte(wc * 32 + fr, fq * 8);
#define PG8_SA(b, h) (((b) * 2 + (h)) * HTB)
#define PG8_SB(b, h) ((4 + (b) * 2 + (h)) * HTB)
#define PG8_STAGE(bufoff, gbase, voff) do { _Pragma("unroll") for (int _i = 0; _i < 2; ++_i) \
        __builtin_amdgcn_global_load_lds((const unsigned*)((const char*)(gbase) + (voff)[_i]), (PG8_LAS unsigned*)(lds + (bufoff) + ldsw + _i * 8192), 16, 0, 0); } while (0)
#define PG8_LDA(dst, b, h) do { _Pragma("unroll") for (int m = 0; m < 4; ++m) _Pragma("unroll") for (int k = 0; k < 2; ++k) dst[m][k] = *(const PG8_LAS bf16x8*)(lds + PG8_SA(b, h) + aoff + m * 2048 + k * 1024); } while (0)
#define PG8_LDB(dst, b, h) do { _Pragma("unroll") for (int n = 0; n < 2; ++n) _Pragma("unroll") for (int k = 0; k < 2; ++k) dst[n][k] = *(const PG8_LAS bf16x8*)(lds + PG8_SB(b, h) + boff + n * 2048 + k * 1024); } while (0)
#define PG8_MMA(ai, bj, At, Bt) do { __builtin_amdgcn_s_setprio(1); _Pragma("unroll") for (int m = 0; m < 4; ++m) _Pragma("unroll") for (int n = 0; n < 2; ++n) _Pragma("unroll") for (int k = 0; k < 2; ++k) \
        acc[ai][bj][m][n] = __builtin_amdgcn_mfma_f32_16x16x32_bf16(Bt[n][k], At[m][k], acc[ai][bj][m][n], 0, 0, 0); __builtin_amdgcn_s_setprio(0); } while (0)
#define PG8_WAIT_V(n) asm volatile("s_waitcnt vmcnt(" #n ")" ::: "memory")
#define PG8_WAIT_L(n) asm volatile("s_waitcnt lgkmcnt(" #n ")" ::: "memory")
#define PG8_BAR __builtin_amdgcn_s_barrier()
#define PG8_SCHED __builtin_amdgcn_sched_barrier(0)
    Unit cur, nxt; int ui = 0;
    if (!S.next(0, cur)) return;
    f32x4 acc[2][2][4][2];
#pragma unroll
    for (int a = 0; a < 2; ++a)
#pragma unroll
        for (int b = 0; b < 2; ++b)
#pragma unroll
            for (int m = 0; m < 4; ++m)
#pragma unroll
                for (int n = 0; n < 2; ++n) acc[a][b][m][n] = (f32x4){0.f, 0.f, 0.f, 0.f};
    bf16x8 At[4][2], B0[2][2], B1[2][2];
    const char* cA = (const char*)g.A + (size_t)cur.pm * tstepA + (size_t)cur.pn * pnA; const char* cB = (const char*)g.Bt + (size_t)cur.pn * tstepB;
    S.a_ready(cur);
    if constexpr (SP2) {
        PG8_STAGE(PG8_SB(0, 0), cB, voffB); PG8_STAGE(PG8_SB(0, 1), cB + hstepB, voffB); PG8_STAGE(PG8_SA(0, 0), cA, voffA); PG8_STAGE(PG8_SA(0, 1), cA + hstepA, voffA);
        if (wr == 1) PG8_BAR;
        PG8_WAIT_V(2); PG8_BAR;
        PG8_STAGE(PG8_SB(1, 0), cB + kstep, voffB); PG8_STAGE(PG8_SA(1, 0), cA + kstep, voffA); PG8_STAGE(PG8_SB(1, 1), cB + hstepB + kstep, voffB);
        PG8_WAIT_V(6); PG8_BAR;
    } else {
        PG8_STAGE(PG8_SB(0, 0), cB, voffB); PG8_STAGE(PG8_SA(0, 0), cA, voffA); PG8_STAGE(PG8_SB(0, 1), cB + hstepB, voffB); PG8_STAGE(PG8_SA(0, 1), cA + hstepA, voffA);
        if (wr == 1) PG8_BAR;
        PG8_WAIT_V(4); PG8_BAR;
        PG8_STAGE(PG8_SB(1, 0), cB + kstep, voffB); PG8_STAGE(PG8_SA(1, 0), cA + kstep, voffA); PG8_STAGE(PG8_SB(1, 1), cB + hstepB + kstep, voffB);
        PG8_WAIT_V(6); PG8_BAR;
    }
    for (;;) {
        const bool has_next = S.next(ui + 1, nxt);
        const char* nA = has_next ? (const char*)g.A + (size_t)nxt.pm * tstepA + (size_t)nxt.pn * pnA : cA; const char* nB = has_next ? (const char*)g.Bt + (size_t)nxt.pn * tstepB : cB;
        for (int t = 0; t < nt; t += 2) {
            const bool last = (t == nt - 2);
            const char* a1 = cA + (size_t)(t + 1) * kstep;
            const char* a2 = last ? nA : cA + (size_t)(t + 2) * kstep; const char* b2 = last ? nB : cB + (size_t)(t + 2) * kstep;
            const char* a3 = a2 + kstep; const char* b3 = b2 + kstep;
            if (last && has_next) S.a_ready(nxt);
            if constexpr (SP2) {
            PG8_LDB(B0, 0, 0); PG8_LDB(B1, 0, 1); PG8_SCHED; PG8_LDA(At, 0, 0); PG8_STAGE(PG8_SA(1, 1), a1 + hstepA, voffA);
            PG8_WAIT_V(8); PG8_WAIT_L(0); PG8_BAR; PG8_MMA(0, 0, At, B0); PG8_MMA(0, 1, At, B1); PG8_BAR; PG8_SCHED;
            PG8_LDA(At, 0, 1); PG8_STAGE(PG8_SB(0, 0), b2, voffB); PG8_STAGE(PG8_SB(0, 1), b2 + hstepB, voffB); PG8_STAGE(PG8_SA(0, 0), a2, voffA);
            PG8_WAIT_V(8); PG8_WAIT_L(0); PG8_BAR; PG8_MMA(1, 0, At, B0); PG8_MMA(1, 1, At, B1); PG8_BAR; PG8_SCHED;
            PG8_LDB(B0, 1, 0); PG8_LDB(B1, 1, 1); PG8_SCHED; PG8_LDA(At, 1, 0); PG8_STAGE(PG8_SA(0, 1), a2 + hstepA, voffA);
            PG8_WAIT_V(8); PG8_WAIT_L(0); PG8_BAR; PG8_MMA(0, 0, At, B0); PG8_MMA(0, 1, At, B1); PG8_BAR; PG8_SCHED;
            PG8_LDA(At, 1, 1); PG8_STAGE(PG8_SB(1, 0), b3, voffB); PG8_STAGE(PG8_SB(1, 1), b3 + hstepB, voffB); PG8_STAGE(PG8_SA(1, 0), a3, voffA);
            PG8_WAIT_V(8); PG8_WAIT_L(0); PG8_BAR; PG8_MMA(1, 0, At, B0); PG8_MMA(1, 1, At, B1); PG8_BAR; PG8_SCHED;
            } else {
            PG8_LDB(B0, 0, 0); PG8_SCHED; PG8_LDA(At, 0, 0); PG8_STAGE(PG8_SA(1, 1), a1 + hstepA, voffA);
            PG8_WAIT_L(8); PG8_BAR; PG8_WAIT_L(0); PG8_MMA(0, 0, At, B0); PG8_BAR; PG8_SCHED;
            PG8_LDB(B1, 0, 1); PG8_STAGE(PG8_SB(0, 0), b2, voffB);
            PG8_BAR; PG8_WAIT_L(0); PG8_MMA(0, 1, At, B1); PG8_BAR;
            PG8_LDA(At, 0, 1); PG8_STAGE(PG8_SA(0, 0), a2, voffA);
            PG8_BAR; PG8_WAIT_L(0); PG8_MMA(1, 0, At, B0); PG8_BAR; PG8_SCHED;
            PG8_STAGE(PG8_SB(0, 1), b2 + hstepB, voffB);
            PG8_WAIT_V(6); PG8_BAR; PG8_MMA(1, 1, At, B1); PG8_BAR;
            PG8_LDB(B0, 1, 0); PG8_SCHED; PG8_LDA(At, 1, 0); PG8_STAGE(PG8_SA(0, 1), a2 + hstepA, voffA);
            PG8_WAIT_L(8); PG8_BAR; PG8_WAIT_L(0); PG8_MMA(0, 0, At, B0); PG8_BAR; PG8_SCHED;
            PG8_LDB(B1, 1, 1); PG8_STAGE(PG8_SB(1, 0), b3, voffB);
            PG8_BAR; PG8_WAIT_L(0); PG8_MMA(0, 1, At, B1); PG8_BAR;
            PG8_LDA(At, 1, 1); PG8_STAGE(PG8_SA(1, 0), a3, voffA);
            PG8_BAR; PG8_WAIT_L(0); PG8_MMA(1, 0, At, B0); PG8_BAR; PG8_SCHED;
            PG8_STAGE(PG8_SB(1, 1), b3 + hstepB, voffB);
            PG8_WAIT_V(6); PG8_BAR; PG8_MMA(1, 1, At, B1); PG8_BAR;
            }
        }
        if constexpr (ALIGN_EPI) { if (wr == 0) PG8_BAR; }
        if constexpr (!Epi::AFTER_DRAIN) { E(acc, cur, wr, wc, fr, fq); S.done(cur); }
        if (!has_next) break;
#pragma unroll
        for (int a = 0; a < 2; ++a)
#pragma unroll
            for (int b = 0; b < 2; ++b)
#pragma unroll
                for (int m = 0; m < 4; ++m)
#pragma unroll
                    for (int n = 0; n < 2; ++n) acc[a][b][m][n] = (f32x4){0.f, 0.f, 0.f, 0.f};
        cur = nxt; cA = nA; cB = nB; ++ui;
        if constexpr (ALIGN_EPI) { if (wr == 1) PG8_BAR; }
    }
    PG8_WAIT_V(0);
    if constexpr (!ALIGN_EPI) { if (wr == 0) PG8_BAR; }
    PG8_BAR;
    if constexpr (Epi::AFTER_DRAIN) { E.fused(acc, cur, wr, wc, fr, fq, lds, wid, lane); S.done(cur); }
#undef PG8_SA
#undef PG8_SB
#undef PG8_STAGE
#undef PG8_LDA
#undef PG8_LDB
#undef PG8_MMA
#undef PG8_WAIT_V
#undef PG8_WAIT_L
#undef PG8_BAR
#undef PG8_SCHED
}

typedef float f32x2 __attribute__((ext_vector_type(2)));
typedef __bf16 hb2 __attribute__((ext_vector_type(2)));
typedef unsigned u32x2 __attribute__((ext_vector_type(2)));
__device__ __forceinline__ unsigned cvt_pk_bf16(float lo, float hi) { f32x2 v = {lo, hi}; return __builtin_bit_cast(unsigned, __builtin_convertvector(v, hb2)); }
__device__ __forceinline__ f32x2 gelu_pk(f32x2 v) {
    const f32x2 av = __builtin_elementwise_abs(v), d = av * 0.2316418882f + 1.0f;
    f32x2 t; t.x = __builtin_amdgcn_rcpf(d.x); t.y = __builtin_amdgcn_rcpf(d.y);
    f32x2 q = t * 0.5307027145f + (-0.7265760135f); q = q * t + 0.7107068705f; q = q * t + (-0.142248368f); q = q * t + 0.127414796f; q = q * t;
    const f32x2 s = (v * v) * (-0.72134752044f);
    f32x2 e; e.x = __builtin_amdgcn_exp2f(s.x); e.y = __builtin_amdgcn_exp2f(s.y);
    const f32x2 m = v * (q * e), r = v - m;
    f32x2 o; o.x = v.x < 0.f ? m.x : r.x; o.y = v.y < 0.f ? m.y : r.y; return o;
}
__device__ __forceinline__ float gelu1(float v) { f32x2 r = gelu_pk((f32x2){v, v}); return r.x; }
constexpr int E_MP = 16384, E_DFF = 2816, E_MODLD = 24576;
__device__ __forceinline__ float row_rinv(const float* rss, int row) { return __builtin_amdgcn_rsqf(rss[row] * (1.0f / 1024.0f) + 1e-6f); }
__device__ __forceinline__ float dpp_ror1(float v) { return __builtin_bit_cast(float, __builtin_amdgcn_update_dpp(0, __builtin_bit_cast(int, v), 0x121, 0xf, 0xf, false)); }
__device__ __forceinline__ float dpp_ror2(float v) { return __builtin_bit_cast(float, __builtin_amdgcn_update_dpp(0, __builtin_bit_cast(int, v), 0x122, 0xf, 0xf, false)); }
__device__ __forceinline__ void ld8(const float* p, float (&v)[8]) { const f32x4 a = *(const f32x4*)p, b = *(const f32x4*)(p + 4); v[0] = a[0]; v[1] = a[1]; v[2] = a[2]; v[3] = a[3]; v[4] = b[0]; v[5] = b[1]; v[6] = b[2]; v[7] = b[3]; }
__device__ __forceinline__ void st8(float* p, const float (&v)[8]) { *(f32x4*)p = (f32x4){v[0], v[1], v[2], v[3]}; *(f32x4*)(p + 4) = (f32x4){v[4], v[5], v[6], v[7]}; }
__device__ __forceinline__ void st8bf(bf16_t* p, const float (&v)[8]) { u32x4 w; w.x = cvt_pk_bf16(v[0], v[1]); w.y = cvt_pk_bf16(v[2], v[3]); w.z = cvt_pk_bf16(v[4], v[5]); w.w = cvt_pk_bf16(v[6], v[7]); *(u32x4*)p = w; }

struct EpiRide {
    const float* cache3; float* out3; int sbase, nunits;
    template <int NPT> __device__ __forceinline__ void load(int L, int tid, f32x4 (&v)[NPT], const f32x4*& src, f32x4*& dst, unsigned& e0, unsigned& n) const {
        constexpr int PPS = 32 / NPT;
        const unsigned sl = (unsigned)(sbase + L / PPS), b = sl >> 4, k = sl & 15u;
        src = (const f32x4*)cache3 + (size_t)b * (2048 * 128) + 512 + (size_t)k * 16384; dst = (f32x4*)out3 + (size_t)b * (2048 * 128) + (size_t)k * 16384;
        n = 261632u - k * 16384u < 16384u ? 261632u - k * 16384u : 16384u; e0 = (unsigned)((L % PPS) * NPT * 512 + tid);
#pragma unroll
        for (int u = 0; u < NPT; ++u) { const unsigned e = e0 + (unsigned)(u * 512); v[u] = __builtin_nontemporal_load(src + (e < n ? e : n - 1u)); }
    }
    template <int NPT> __device__ __forceinline__ void store(const f32x4 (&v)[NPT], f32x4* dst, unsigned e0, unsigned n) const {
#pragma unroll
        for (int u = 0; u < NPT; ++u) { const unsigned e = e0 + (unsigned)(u * 512); if (e < n) __builtin_nontemporal_store(v[u], dst + e); }
    }
};
struct EpiMod {
    static constexpr bool PERM = true, AFTER_DRAIN = false;
    float* mod; const float* b_ada; bf16_t* sh;
    __device__ __forceinline__ void operator()(const f32x4 (&acc)[2][2][4][2], const Unit& u, int wr, int wc, int fr, int fq) const {
        const int l = u.pn / 24, rem = u.pn % 24, mi = rem >> 2, cbk = rem & 3;
        const int variant = (mi == 3) ? l : ((mi == 0 && l == 1) ? 4 : ((mi == 0 && l == 2) ? 5 : -1));
#pragma unroll
        for (int bj = 0; bj < 2; ++bj) {
            const int col0 = u.pn * 256 + bj * 128 + wc * 32 + 8 * fq;
            float bv[8]; ld8(b_ada + col0, bv);
#pragma unroll
            for (int ai = 0; ai < 2; ++ai)
#pragma unroll
                for (int m = 0; m < 4; ++m) {
                    const int row = ai * 128 + wr * 64 + m * 16 + fr;
                    float v[8];
#pragma unroll
                    for (int j = 0; j < 4; ++j) { v[j] = acc[ai][bj][m][0][j] + bv[j]; v[4 + j] = acc[ai][bj][m][1][j] + bv[4 + j]; }
                    if (row < 136) st8(mod + (size_t)row * E_MODLD + col0, v);
                    if (variant >= 0) st8bf(sh + ((size_t)(variant * 256 + row)) * 1024 + cbk * 256 + bj * 128 + wc * 32 + 8 * fq, v);
                }
        }
    }
};
struct EpiCb {
    static constexpr bool PERM = true, AFTER_DRAIN = false;
    float* cb;
    __device__ __forceinline__ void operator()(const f32x4 (&acc)[2][2][4][2], const Unit& u, int wr, int wc, int fr, int fq) const {
        const int v = u.pm; const int nv = v < 4 ? 5632 : (v == 4 ? 2304 : 3328); const int toff = v < 4 ? 22 * v : (v == 4 ? 88 : 97);
        const size_t base = v < 4 ? (size_t)v * 256 * 5632 : (v == 4 ? (size_t)4 * 256 * 5632 : (size_t)4 * 256 * 5632 + (size_t)256 * 2304);
#pragma unroll
        for (int bj = 0; bj < 2; ++bj) {
            const int col0 = (u.pn - toff) * 256 + bj * 128 + wc * 32 + 8 * fq;
#pragma unroll
            for (int ai = 0; ai < 2; ++ai)
#pragma unroll
                for (int m = 0; m < 4; ++m) {
                    const int row = ai * 128 + wr * 64 + m * 16 + fr;
                    float vv[8];
#pragma unroll
                    for (int j = 0; j < 4; ++j) { vv[j] = acc[ai][bj][m][0][j]; vv[4 + j] = acc[ai][bj][m][1][j]; }
                    st8(cb + base + (size_t)row * nv + col0, vv);
                }
        }
    }
};
struct EpiRes {
    static constexpr bool PERM = true, AFTER_DRAIN = false;
    const float* xin_p; const float* xin_s;
    float* xout;
    const float* gate;
    const float* pscale;
    const float* ngain; const float* nscale;
    bf16_t* an; float* rss;
    const float* fgain; unsigned* pcnt;
    __device__ __forceinline__ void operator()(const f32x4 (&acc)[2][2][4][2], const Unit& u, int wr, int wc, int fr, int fq) const {
        const int bi = u.pm >> 3;
        float gt[2][8], gn[2][8];
#pragma unroll
        for (int bj = 0; bj < 2; ++bj) {
            const int col0 = u.pn * 256 + bj * 128 + wc * 32 + 8 * fq;
            ld8(gate + (size_t)bi * E_MODLD + col0, gt[bj]);
            if (pscale) { float ps[8]; ld8(pscale + col0, ps);
#pragma unroll
                for (int j = 0; j < 8; ++j) gt[bj][j] *= ps[j]; }
            if (ngain) { float ns[8]; ld8(ngain + col0, gn[bj]); ld8(nscale + (size_t)bi * E_MODLD + col0, ns);
#pragma unroll
                for (int j = 0; j < 8; ++j) gn[bj][j] *= (1.0f + ns[j]); }
        }
#pragma unroll
        for (int ai = 0; ai < 2; ++ai)
#pragma unroll
            for (int m = 0; m < 4; ++m) {
                const int row = u.pm * 256 + ai * 128 + wr * 64 + m * 16 + fr;
                float ss = 0.f;
#pragma unroll
                for (int bj = 0; bj < 2; ++bj) {
                    const int col0 = u.pn * 256 + bj * 128 + wc * 32 + 8 * fq;
                    float xo[8], xn[8];
                    ld8(xin_p + (size_t)row * 1024 + col0, xo);
#pragma unroll
                    for (int j = 0; j < 4; ++j) { xn[j] = xo[j] + gt[bj][j] * acc[ai][bj][m][0][j]; xn[4 + j] = xo[4 + j] + gt[bj][4 + j] * acc[ai][bj][m][1][j]; }
                    if (fgain) st8(xout + (size_t)row * 1024 + col0, xn);
                    else { __builtin_nontemporal_store((f32x4){xn[0], xn[1], xn[2], xn[3]}, (f32x4*)(xout + (size_t)row * 1024 + col0)); __builtin_nontemporal_store((f32x4){xn[4], xn[5], xn[6], xn[7]}, (f32x4*)(xout + (size_t)row * 1024 + col0 + 4)); }
#pragma unroll
                    for (int j = 0; j < 8; ++j) ss += xn[j] * xn[j];
                    if (ngain) { float o[8];
#pragma unroll
                        for (int j = 0; j < 8; ++j) o[j] = xn[j] * gn[bj][j];
                        st8bf(an + (size_t)row * 1024 + col0, o); }
                }
                ss += __shfl_xor(ss, 16); ss += __shfl_xor(ss, 32);
                if (fq == 0) atomicAdd(rss + row, ss);
                if (m & 1) asm volatile("" ::: "memory");
            }
        if (fgain) {
            asm volatile("s_waitcnt vmcnt(0)" ::: "memory");
            unsigned* cw = pcnt + 64 * u.pm;
            if (fr == 0 && fq == 0) __hip_atomic_fetch_add(cw, 1u, __ATOMIC_RELAXED, __HIP_MEMORY_SCOPE_AGENT);
            { unsigned sp = 0; while (__hip_atomic_load(cw, __ATOMIC_RELAXED, __HIP_MEMORY_SCOPE_AGENT) < 32u) { __builtin_amdgcn_s_sleep(1); if (++sp > (1u << 20)) break; } }
            __builtin_amdgcn_fence(__ATOMIC_ACQUIRE, "agent");
            asm volatile("s_waitcnt vmcnt(0)" ::: "memory");
            float fg[2][8];
#pragma unroll
            for (int bj = 0; bj < 2; ++bj) ld8(fgain + u.pn * 256 + bj * 128 + wc * 32 + 8 * fq, fg[bj]);
#pragma unroll
            for (int ai = 0; ai < 2; ++ai)
#pragma unroll
                for (int m = 0; m < 4; ++m) {
                    const int row = u.pm * 256 + ai * 128 + wr * 64 + m * 16 + fr;
                    const float rinv = __builtin_amdgcn_rsqf(__hip_atomic_load(rss + row, __ATOMIC_RELAXED, __HIP_MEMORY_SCOPE_AGENT) * (1.0f / 1024.0f) + 1e-6f);
#pragma unroll
                    for (int bj = 0; bj < 2; ++bj) {
                        const int col0 = u.pn * 256 + bj * 128 + wc * 32 + 8 * fq;
                        float xn[8]; ld8(xout + (size_t)row * 1024 + col0, xn);
#pragma unroll
                        for (int j = 0; j < 8; ++j) xn[j] = xn[j] * rinv * fg[bj][j];
                        st8(xout + (size_t)row * 1024 + col0, xn);
                    }
                    if (m & 1) asm volatile("" ::: "memory");
                }
        }
    }
};
struct EpiFfnIn {
    static constexpr bool PERM = true, AFTER_DRAIN = false;
    const float* rss; const float* cb;
    const float* cw; const float* cbv;
    const float* cstate;
    bf16_t* act;
    float* hg; float* hu; float* tg;
    float* conv_p; float* conv_s;
    EpiRide ride;
    __device__ __forceinline__ void operator()(const f32x4 (&acc)[2][2][4][2], const Unit& u, int wr, int wc, int fr, int fq) const {
        const bool prompt = u.pm < 64;
        const int rL = u.pm * 22 + u.pn; const bool rdo = rL < ride.nunits; f32x4 rv_[1]; const f32x4* rs_ = nullptr; f32x4* rd_ = nullptr; unsigned re_ = 0u, rn_ = 0u;
        if (rdo) ride.load<1>(rL, (wr * 4 + wc) * 64 + fq * 16 + fr, rv_, rs_, rd_, re_, rn_);
        float rv[2][4];
#pragma unroll
        for (int ai = 0; ai < 2; ++ai)
#pragma unroll
            for (int m = 0; m < 4; ++m) rv[ai][m] = row_rinv(rss, u.pm * 256 + ai * 128 + wr * 64 + m * 16 + fr);
#pragma unroll
        for (int n = 0; n < 2; ++n) {
            const int gc0 = u.pn * 128 + wc * 32 + 8 * fq + 4 * n;
            const int cc0 = u.pn * 256 + wc * 32 + 8 * fq + 4 * n;
            const f32x4 w0 = *(const f32x4*)(cw + gc0), w1 = *(const f32x4*)(cw + E_DFF + gc0), w2 = *(const f32x4*)(cw + 2 * E_DFF + gc0), bb = *(const f32x4*)(cbv + gc0);
            if (prompt) {
                const int bi = u.pm >> 3;
                const f32x4 cg = *(const f32x4*)(cb + (size_t)bi * 5632 + cc0), cu = *(const f32x4*)(cb + (size_t)bi * 5632 + cc0 + 128);
#pragma unroll
                for (int ai = 0; ai < 2; ++ai) {
                    f32x4 gp = {0.f, 0.f, 0.f, 0.f};
#pragma unroll
                    for (int m = 0; m < 4; ++m) {
                        const int row = u.pm * 256 + ai * 128 + wr * 64 + m * 16 + fr;
                        const float rinv = rv[ai][m];
                        const f32x4 g = acc[ai][0][m][n] * rinv + cg, uu = acc[ai][1][m][n] * rinv + cu;
                        f32x4 a;
#pragma unroll
                        for (int j = 0; j < 4; ++j) {
                            const float r1c = dpp_ror1(g[j]), r2c = dpp_ror2(g[j]), r1p = dpp_ror1(gp[j]), r2p = dpp_ror2(gp[j]);
                            const float gm1 = fr >= 1 ? r1c : r1p, gm2 = fr >= 2 ? r2c : r2p;
                            a[j] = w0[j] * gm2 + w1[j] * gm1 + w2[j] * g[j] + bb[j];
                        }
                        const f32x2 e0 = gelu_pk((f32x2){a[0], a[1]}), e1 = gelu_pk((f32x2){a[2], a[3]});
                        const int strip = row >> 6;
                        if (m > 0 || fr >= 2) { u32x2 w; w.x = cvt_pk_bf16(e0.x * uu[0], e0.y * uu[1]); w.y = cvt_pk_bf16(e1.x * uu[2], e1.y * uu[3]); *(u32x2*)(act + (size_t)row * E_DFF + gc0) = w; }
                        if (m == 0 && fr < 2) { *(f32x4*)(hg + ((size_t)strip * 2 + fr) * E_DFF + gc0) = g; *(f32x4*)(hu + ((size_t)strip * 2 + fr) * E_DFF + gc0) = uu; }
                        if (m == 3 && fr >= 14) { *(f32x4*)(tg + ((size_t)strip * 2 + (fr - 14)) * E_DFF + gc0) = g;
                            if ((strip & 31) == 31) *(f32x4*)(conv_p + ((size_t)bi * 2 + (fr - 14)) * E_DFF + gc0) = g; }
                        gp = g;
                        asm volatile("" ::: "memory");
                    }
                }
            } else {
#pragma unroll
                for (int ai = 0; ai < 2; ++ai)
#pragma unroll
                    for (int m = 0; m < 4; ++m) {
                        const int row = u.pm * 256 + ai * 128 + wr * 64 + m * 16 + fr;
                        const int rs = row - E_MP, b = rs >> 2, t = rs & 3, bi = 8 + b;
                        const float rinv = rv[ai][m];
                        const f32x4 cg = *(const f32x4*)(cb + (size_t)bi * 5632 + cc0), cu = *(const f32x4*)(cb + (size_t)bi * 5632 + cc0 + 128);
                        const f32x4 s0 = *(const f32x4*)(cstate + ((size_t)b * 2 + 0) * E_DFF + gc0), s1 = *(const f32x4*)(cstate + ((size_t)b * 2 + 1) * E_DFF + gc0);
                        const f32x4 g = acc[ai][0][m][n] * rinv + cg, uu = acc[ai][1][m][n] * rinv + cu;
                        f32x4 a;
#pragma unroll
                        for (int j = 0; j < 4; ++j) {
                            const float r1c = dpp_ror1(g[j]), r2c = dpp_ror2(g[j]);
                            const float gm1 = t >= 1 ? r1c : s1[j], gm2 = t >= 2 ? r2c : (t == 1 ? s1[j] : s0[j]);
                            a[j] = w0[j] * gm2 + w1[j] * gm1 + w2[j] * g[j] + bb[j];
                        }
                        const f32x2 e0 = gelu_pk((f32x2){a[0], a[1]}), e1 = gelu_pk((f32x2){a[2], a[3]});
                        { u32x2 w; w.x = cvt_pk_bf16(e0.x * uu[0], e0.y * uu[1]); w.y = cvt_pk_bf16(e1.x * uu[2], e1.y * uu[3]); *(u32x2*)(act + (size_t)row * E_DFF + gc0) = w; }
                        if (t >= 2) *(f32x4*)(conv_s + ((size_t)b * 2 + (t - 2)) * E_DFF + gc0) = g;
                        asm volatile("" ::: "memory");
                    }
            }
        }
        if (rdo) ride.store<1>(rv_, rd_, re_, rn_);
    }
};
struct EpiQkv {
    static constexpr bool PERM = true, AFTER_DRAIN = false;
    const float* rss; const float* cb;
    bf16_t* qkv;
    float* out;
    EpiRide ride;
    __device__ __forceinline__ void operator()(const f32x4 (&acc)[2][2][4][2], const Unit& u, int wr, int wc, int fr, int fq) const {
        const int rL = u.pm * 9 + u.pn; const bool rdo = rL < ride.nunits; f32x4 rv_[4]; const f32x4* rs_ = nullptr; f32x4* rd_ = nullptr; unsigned re_ = 0u, rn_ = 0u;
        if (rdo) ride.load<4>(rL, (wr * 4 + wc) * 64 + fq * 16 + fr, rv_, rs_, rd_, re_, rn_);
        const int sec = u.pn / 3, g = u.pn % 3, W = 128 << (2 * g);
        bf16_t* dst = qkv + (size_t)sec * ((WS_KB - WS_QB) / 2);
        const size_t offp = g == 0 ? O_W1P : (g == 1 ? O_W2P : O_W3P), offs = g == 0 ? O_W1S : (g == 1 ? O_W2S : O_W3S);
        float* wp = out + offp; float* ws = out + offs;
        const float sc = sec == 0 ? 0.125f : 1.0f;
        const bool prompt = u.pm < 64;
        float rv[2][4], cbv[2][8];
#pragma unroll
        for (int ai = 0; ai < 2; ++ai)
#pragma unroll
            for (int m = 0; m < 4; ++m) rv[ai][m] = row_rinv(rss, u.pm * 256 + ai * 128 + wr * 64 + m * 16 + fr) * sc;
#pragma unroll
        for (int bj = 0; bj < 2; ++bj) ld8(cb + (size_t)(prompt ? (u.pm >> 3) : 0) * 2304 + u.pn * 256 + bj * 128 + wc * 32 + 8 * fq, cbv[bj]);
#pragma unroll
        for (int ai = 0; ai < 2; ++ai)
#pragma unroll
            for (int m = 0; m < 4; ++m) {
                const int row = u.pm * 256 + ai * 128 + wr * 64 + m * 16 + fr;
                const int bi = prompt ? (u.pm >> 3) : 8 + ((row - E_MP) >> 2);
                const float rinv = rv[ai][m];
#pragma unroll
                for (int bj = 0; bj < 2; ++bj) {
                    const int lc = bj * 128 + wc * 32 + 8 * fq;
                    float c8[8], v[8]; if (prompt) {
#pragma unroll
                        for (int j = 0; j < 8; ++j) c8[j] = cbv[bj][j]; } else ld8(cb + (size_t)bi * 2304 + u.pn * 256 + lc, c8);
#pragma unroll
                    for (int j = 0; j < 4; ++j) { v[j] = rinv * acc[ai][bj][m][0][j] + sc * c8[j]; v[4 + j] = rinv * acc[ai][bj][m][1][j] + sc * c8[4 + j]; }
                    st8bf(dst + (size_t)row * 768 + g * 256 + lc, v);
                    if (sec > 0) {
                        if (prompt) { const int t = row & 2047; if (t >= 2048 - W) st8(wp + (((size_t)bi * W + (t - (2048 - W))) * 2 + (sec - 1)) * 256 + lc, v); }
                        else { const int rs = row - E_MP, b = rs >> 2, t = rs & 3; st8(ws + (((size_t)b * W + (W - 4 + t)) * 2 + (sec - 1)) * 256 + lc, v); }
                    }
                }
                asm volatile("" ::: "memory");
            }
        if (rdo) ride.store<4>(rv_, rd_, re_, rn_);
    }
};
struct EpiGlaIn {
    static constexpr bool PERM = true, AFTER_DRAIN = false;
    const float* rss; const float* cb;
    bf16_t* base;
    float* gd;
    EpiRide ride;
    __device__ __forceinline__ void operator()(const f32x4 (&acc)[2][2][4][2], const Unit& u, int wr, int wc, int fr, int fq) const {
        const int rL = u.pm * 13 + u.pn; const bool rdo = rL < ride.nunits; f32x4 rv_[4]; const f32x4* rs_ = nullptr; f32x4* rd_ = nullptr; unsigned re_ = 0u, rn_ = 0u;
        if (rdo) ride.load<4>(rL, (wr * 4 + wc) * 64 + fq * 16 + fr, rv_, rs_, rd_, re_, rn_);
        const int pn = u.pn;
        const size_t doff = pn < 2 ? 0 : (pn < 4 ? (WS_GK - WS_GQ) / 2 : (pn < 8 ? (WS_GV - WS_GQ) / 2 : (WS_GR - WS_GQ) / 2));
        const int ld = pn < 4 ? 512 : 1024, tcol = (pn < 2 ? pn : (pn < 4 ? pn - 2 : (pn < 8 ? pn - 4 : pn - 8))) * 256;
        bf16_t* dst = base + doff;
        const float sc = pn < 2 ? 0.08838834764831845f : 1.0f;
        const bool prompt = u.pm < 64;
        float rv[2][4], cbv[2][8];
#pragma unroll
        for (int ai = 0; ai < 2; ++ai)
#pragma unroll
            for (int m = 0; m < 4; ++m) rv[ai][m] = row_rinv(rss, u.pm * 256 + ai * 128 + wr * 64 + m * 16 + fr) * sc;
#pragma unroll
        for (int bj = 0; bj < 2; ++bj) ld8(cb + (size_t)(prompt ? (u.pm >> 3) : 0) * 3328 + pn * 256 + bj * 128 + wc * 32 + 8 * fq, cbv[bj]);
#pragma unroll
        for (int ai = 0; ai < 2; ++ai)
#pragma unroll
            for (int m = 0; m < 4; ++m) {
                const int row = u.pm * 256 + ai * 128 + wr * 64 + m * 16 + fr;
                const int bi = prompt ? (u.pm >> 3) : 8 + ((row - E_MP) >> 2);
                const float rinv = rv[ai][m];
#pragma unroll
                for (int bj = 0; bj < 2; ++bj) {
                    const int lc = bj * 128 + wc * 32 + 8 * fq;
                    float c8[8], v[8]; if (prompt) {
#pragma unroll
                        for (int j = 0; j < 8; ++j) c8[j] = cbv[bj][j]; } else ld8(cb + (size_t)bi * 3328 + pn * 256 + lc, c8);
#pragma unroll
                    for (int j = 0; j < 4; ++j) { v[j] = rinv * acc[ai][bj][m][0][j] + sc * c8[j]; v[4 + j] = rinv * acc[ai][bj][m][1][j] + sc * c8[4 + j]; }
                    if (pn < 12) st8bf(dst + (size_t)row * ld + tcol + lc, v);
                    else if (lc < 16) st8(gd + (size_t)row * 16 + lc, v);
                }
                asm volatile("" ::: "memory");
            }
        if (rdo) ride.store<4>(rv_, rd_, re_, rn_);
    }
};
}
constexpr int RING_OFF = 0, RING_BYTES = 133120;
constexpr int LDSCTL_OFF = RING_BYTES, MISC_OFF = LDSCTL_OFF + 320;
constexpr int LDS_BYTES = 147456;
constexpr int NWAVES = 8;

#define XB_TMO      128
#define XB_XCNT(j)  (256  + 64 * (j))
#define XB_XSUB(j)  (1280 + 64 * (j))
#define XB_XGEN(j)  (2304 + 64 * (j))
#define XB_TOP      3328
#define XB_TOPGEN   3392
#define XCD_BAR_WORDS 3456
#define XB_SPIN_CAP (1u << 18)
__device__ __forceinline__ unsigned xb_ld(unsigned* p)              { return __hip_atomic_load(p, __ATOMIC_RELAXED, __HIP_MEMORY_SCOPE_AGENT); }
__device__ __forceinline__ unsigned xb_add(unsigned* p, unsigned v) { return __hip_atomic_fetch_add(p, v, __ATOMIC_RELAXED, __HIP_MEMORY_SCOPE_AGENT); }
__device__ __forceinline__ unsigned xb_xcc_id() { return (unsigned)__builtin_amdgcn_s_getreg((3 << 11) | 20) & 0xFu; }
#define XB_SPIN(cond, bar) do { unsigned _sp = 0; while (cond) { __builtin_amdgcn_s_sleep(1); \
    if ((++_sp & 255u) == 0u) { if (xb_ld(&(bar)[XB_TMO])) break; if (_sp > XB_SPIN_CAP) { atomicAdd(&(bar)[XB_TMO], 1u); break; } } } } while (0)
struct XcdBarrier { unsigned* bar; unsigned x; volatile LAS unsigned* st; };
__device__ __forceinline__ XcdBarrier xcd_barrier_post(unsigned* bar, volatile LAS unsigned* st, int tid) {
    XcdBarrier b; b.bar = bar; b.x = xb_xcc_id(); b.st = st;
    if (tid == 0) (void)xb_add(&bar[XB_XCNT(b.x)], 1u);
    return b;
}
__device__ __forceinline__ void xcd_barrier_complete(unsigned* bar, unsigned x, unsigned& nloc, unsigned& nx) {
    const unsigned G = gridDim.x * gridDim.y * gridDim.z;
    unsigned sum, cnt, mine, sp = 0u;
    for (;;) {
        sum = 0u; cnt = 0u; mine = 0u;
#pragma unroll
        for (unsigned j = 0; j < 16; ++j) { const unsigned c = xb_ld(&bar[XB_XCNT(j)]); sum += c; cnt += (c > 0u) ? 1u : 0u; mine = (j == x) ? c : mine; }
        if (sum == G) break;
        __builtin_amdgcn_s_sleep(1);
        if ((++sp & 255u) == 0u) { if (xb_ld(&bar[XB_TMO])) break; if (sp > XB_SPIN_CAP) { atomicAdd(&bar[XB_TMO], 1u); break; } }
    }
    nloc = mine > 0u ? mine : 1u; nx = cnt > 0u ? cnt : 1u;
}
__device__ __forceinline__ void xcd_barrier(const XcdBarrier& b, int tid) {
    asm volatile("s_waitcnt vmcnt(0)" ::: "memory");
    __syncthreads();
    if (tid == 0) {
        unsigned* bar = b.bar;
        __builtin_amdgcn_s_waitcnt(0);
        unsigned nloc = b.st[0], nx = b.st[1];
        if (nloc == 0u) { xcd_barrier_complete(bar, b.x, nloc, nx); b.st[0] = nloc; b.st[1] = nx; }
        const unsigned old = xb_add(&bar[XB_XSUB(b.x)], 1u);
        const unsigned gen = old / nloc;
        if (old + 1u == (gen + 1u) * nloc) {
            __builtin_amdgcn_fence(__ATOMIC_RELEASE, "agent");
            asm volatile("s_waitcnt vmcnt(0)" ::: "memory");
            const unsigned og = xb_add(&bar[XB_TOP], 1u);
            const unsigned tg = og / nx;
            if (og + 1u == (tg + 1u) * nx) xb_add(&bar[XB_TOPGEN], 1u);
            else XB_SPIN(xb_ld(&bar[XB_TOPGEN]) == tg, bar);
            __builtin_amdgcn_fence(__ATOMIC_ACQUIRE, "agent");
            xb_add(&bar[XB_XGEN(b.x)], 1u);
            asm volatile("s_waitcnt vmcnt(0)" ::: "memory");
        } else {
            XB_SPIN(xb_ld(&bar[XB_XGEN(b.x)]) == gen, bar);
            __builtin_amdgcn_fence(__ATOMIC_ACQUIRE, "agent");
            asm volatile("s_waitcnt vmcnt(0)" ::: "memory");
        }
    }
    __syncthreads();
}

struct Frame {
    LAS unsigned char* lds;
    int tid, lane, wave, G, bid;
    const __attribute__((address_space(4))) unsigned char* ka;
    __device__ __forceinline__ const float* inp(int k) const { return (const float*)(*(const GAS float* const __attribute__((address_space(4)))*)(ka + 8 * k)); }
    GAS float* out_g; GAS unsigned char* ws_g;
};
#define F_WS ((unsigned char*)F.ws_g)
#define F_OUT ((float*)F.out_g)
#define WSP(T, off) ((T*)(F_WS + (off)))
#define RIDE_LOAD(N, V, CB, E0) do { _Pragma("unroll") for (int u_ = 0; u_ < (N); ++u_) { const unsigned e_ = (unsigned)(E0) + (unsigned)(u_ * 512) + (unsigned)F.tid; (V)[u_] = __builtin_nontemporal_load((CB).src + (e_ < (CB).n ? e_ : (CB).n - 1u)); } } while (0)
#define RIDE_STORE(N, V, CB, E0) do { _Pragma("unroll") for (int u_ = 0; u_ < (N); ++u_) { const unsigned e_ = (unsigned)(E0) + (unsigned)(u_ * 512) + (unsigned)F.tid; if (e_ < (CB).n) __builtin_nontemporal_store((V)[u_], (CB).dst + e_); } } while (0)

constexpr unsigned CP_SLICE_F4 = 16384u, CP_NSTATIC = 1513u;
struct CpBase { const f32x4* src; f32x4* dst; unsigned n; };
__device__ __forceinline__ CpBase copy_base(Frame& F, unsigned s) {
    const unsigned b = s >> 4, k = s & 15u, per_b = 2044u * 128u;
    CpBase c; c.src = (const f32x4*)F.inp(5) + (size_t)b * (2048 * 128) + 512 + (size_t)k * CP_SLICE_F4; c.dst = (f32x4*)(F_OUT + O_W3S) + (size_t)b * (2048 * 128) + (size_t)k * CP_SLICE_F4;
    c.n = per_b - k * CP_SLICE_F4 < CP_SLICE_F4 ? per_b - k * CP_SLICE_F4 : CP_SLICE_F4; return c;
}


__device__ __forceinline__ void p0_transpose_item(const float* W, int K, int N, bf16* WT, int ldt, int drow0, LAS float* scr, int kb, int nb, int lane) {
    const int k0 = 64 * kb, n0 = 32 * nb;
#pragma unroll
    for (int i = 0; i < 32; ++i) { const int kk = 2 * i + (lane >> 5); const int n = n0 + (lane & 31); scr[kk * 33 + (lane & 31)] = (n < N) ? W[(size_t)(k0 + kk) * N + n] : 0.f; }
    LDS_WAIT(); asm volatile("" ::: "memory");
    const int c = lane & 7;
#pragma unroll
    for (int j = 0; j < 4; ++j) { const int n = (lane >> 3) + 8 * j; const LAS float* s = scr + (8 * c) * 33 + n;
        v4u o; o.x = pk2(s[0 * 33], s[1 * 33]); o.y = pk2(s[2 * 33], s[3 * 33]); o.z = pk2(s[4 * 33], s[5 * 33]); o.w = pk2(s[6 * 33], s[7 * 33]);
        *(v4u*)(WT + (size_t)(drow0 + n) * ldt + k0 + 8 * c) = o; }
    LDS_WAIT(); asm volatile("" ::: "memory");
}
__device__ __forceinline__ void p0_prologue(Frame& F) {
    LAS float* scr = (LAS float*)(F.lds + RING_OFF + F.wave * 16384);
    const int gw = F.bid * NWAVES + F.wave, NGW = F.G * NWAVES;
    constexpr int I_FI = 16 * 176, I_QKV = 16 * 72, I_GI = 16 * 97, I_FD = 44 * 32, I_AO = 12 * 32, I_GO = 16 * 32, I_PW = 4 * 8;
    constexpr int NITEMS = 4 * I_FI + I_QKV + I_GI + 4 * I_FD + I_AO + I_GO + 8 * I_PW;
    for (int it = gw; it < NITEMS; it += NGW) {
        int r = it;
        if (r < 4 * I_FI) { const int l = r / I_FI, q = r % I_FI, kb = q / 176, nb = q % 176, n0 = 32 * nb, half = n0 / DFF, jn = n0 % DFF;
            p0_transpose_item(F.inp(24) + (size_t)l * 1024 * 5632, 1024, 5632, WSP(bf16, WS_WNF) + (size_t)l * 5632 * 1024, 1024, (jn / 128) * 256 + half * 128 + (jn % 128), scr, kb, nb, F.lane); continue; }
        r -= 4 * I_FI;
        if (r < I_QKV) { const int kb = r / 72, nb = r % 72; p0_transpose_item(F.inp(17), 1024, 2304, WSP(bf16, WS_WNF) + (size_t)22528 * 1024, 1024, 32 * nb, scr, kb, nb, F.lane); continue; }
        r -= I_QKV;
        if (r < I_GI) { const int kb = r / 97, nb = r % 97; p0_transpose_item(F.inp(19), 1024, 3088, WSP(bf16, WS_WNF) + (size_t)24832 * 1024, 1024, 32 * nb, scr, kb, nb, F.lane); continue; }
        r -= I_GI;
        if (r < 4 * I_FD) { const int l = r / I_FD, q = r % I_FD, kb = q / 32, nb = q % 32; p0_transpose_item(F.inp(27) + (size_t)l * DFF * 1024, DFF, 1024, WSP(bf16, WS_WD) + (size_t)l * 1024 * DFF, DFF, 32 * nb, scr, kb, nb, F.lane); continue; }
        r -= 4 * I_FD;
        if (r < I_AO) { const int kb = r / 32, nb = r % 32; p0_transpose_item(F.inp(18), 768, 1024, WSP(bf16, WS_WAO), 768, 32 * nb, scr, kb, nb, F.lane); continue; }
        r -= I_AO;
        if (r < I_GO) { const int kb = r / 32, nb = r % 32; p0_transpose_item(F.inp(23), 1024, 1024, WSP(bf16, WS_WGO), 1024, 32 * nb, scr, kb, nb, F.lane); continue; }
        r -= I_GO;
        { const int jg = r / I_PW, q = r % I_PW, kb = q / 8, nb = q % 8;
            p0_transpose_item(F.inp(15) + (size_t)jg * 65536, 256, 256, WSP(bf16, WS_WP) + (size_t)(jg >> 2) * 1024 * 256, 256, (jg & 3) * 256 + 32 * nb, scr, kb, nb, F.lane); }
    }
}

__device__ __forceinline__ void mod_direct_phase(Frame& F) {
    LAS bf16* A_l = (LAS bf16*)(F.lds + RING_OFF);
    float* mod = WSP(float, WS_MOD); bf16* sh = WSP(bf16, WS_SH);
    const int fr = F.lane & 15, fq = F.lane >> 4, w = F.wave;
    for (int slab = F.bid; slab < 256; slab += F.G) {
        const int l = slab >> 6, cl0 = (slab & 63) * 96;
        const float* Wl = F.inp(10) + (size_t)l * 1024 * 6144 + cl0 + 16 * w + fr;
        f32x4 acc[9];
#pragma unroll
        for (int rb = 0; rb < 9; ++rb) acc[rb] = (f32x4){0.f, 0.f, 0.f, 0.f};
#pragma unroll 1
        for (int kc = 0; kc < 4; ++kc) {
            asm volatile("" ::: "memory");
            __syncthreads();
#pragma unroll
            for (int q = 0; q < 9; ++q) { const int id = F.tid + 512 * q, row = id >> 5, c8 = (id & 31) * 8; v4u o = {0u, 0u, 0u, 0u};
                if (row < NBI) { const float* src = (row < NBP ? F.inp(8) + (size_t)row * D : F.inp(9) + (size_t)(row - NBP) * D) + 256 * kc + c8;
                    const f32x4 a = *(const f32x4*)src, b = *(const f32x4*)(src + 4); float v[8] = {a[0], a[1], a[2], a[3], b[0], b[1], b[2], b[3]};
#pragma unroll
                    for (int j = 0; j < 8; ++j) v[j] = v[j] / (1.0f + __expf(-v[j]));
                    o.x = pk2(v[0], v[1]); o.y = pk2(v[2], v[3]); o.z = pk2(v[4], v[5]); o.w = pk2(v[6], v[7]); }
                *(LAS v4u*)(A_l + row * 264 + c8) = o; }
            __syncthreads();
            if (w < 6) {
                const float* wp = Wl + (size_t)(256 * kc + 8 * fq) * 6144;
#pragma unroll 1
                for (int kh = 0; kh < 2; ++kh) {
                    float bw[4][8];
#pragma unroll
                    for (int ks = 0; ks < 4; ++ks)
#pragma unroll
                        for (int j = 0; j < 8; ++j) bw[ks][j] = wp[(size_t)(32 * ks + j) * 6144];
#pragma unroll
                    for (int ks = 0; ks < 4; ++ks) {
                        v4u bp; bp.x = pk2(bw[ks][0], bw[ks][1]); bp.y = pk2(bw[ks][2], bw[ks][3]); bp.z = pk2(bw[ks][4], bw[ks][5]); bp.w = pk2(bw[ks][6], bw[ks][7]);
                        const bf16x8 bfrag = __builtin_bit_cast(bf16x8, bp);
#pragma unroll
                        for (int rb = 0; rb < 9; ++rb) { const bf16x8 a = *(const LAS bf16x8*)(A_l + (16 * rb + fr) * 264 + 128 * kh + 32 * ks + 8 * fq); acc[rb] = MFMA16(a, bfrag, acc[rb]); }
                    }
                    wp += (size_t)128 * 6144;
                    asm volatile("" ::: "memory");
                }
            }
        }
        if (w < 6) {
            const int col = cl0 + 16 * w + fr, mi = col >> 10, cc = col & 1023;
            const int variant = (mi == 3) ? l : ((mi == 0 && l == 1) ? 4 : ((mi == 0 && l == 2) ? 5 : -1));
            const float bias = F.inp(11)[l * 6144 + col];
#pragma unroll
            for (int rb = 0; rb < 9; ++rb)
#pragma unroll
                for (int j = 0; j < 4; ++j) { const int row = 16 * rb + 4 * fq + j; const float v = acc[rb][j] + bias;
                    if (row < NBI) mod[(size_t)row * MODLD + l * 6144 + col] = v;
                    if (variant >= 0) sh[((size_t)variant * 256 + row) * 1024 + cc] = (bf16)(pk2(v, 0.f) & 0xffffu); }
        }
    }
}
template <int W, int NNEW, bool SAMPLE>
__device__ __forceinline__ void pool_march(const float* xrow0  , int t0, const float* past  ,
                                           const LAS float* rinv_l, int c0, float G0, float G1, float sh0, float sh1, bf16* drow0  , float* st_out  , int st_first  ) {
    float r0[W], r1[W]; float s0 = 0.f, s1 = 0.f;
#pragma unroll
    for (int j = 0; j < W; ++j) { r0[j] = 0.f; r1[j] = 0.f; }
    constexpr int NTOT = 15 + NNEW, NBLK = (NTOT + 15) / 16;
#define POOL_LOAD(BLK, XV) do { _Pragma("unroll") for (int jj = 0; jj < 16; ++jj) { const int i = (BLK) * 16 + jj < NTOT ? (BLK) * 16 + jj : NTOT - 1;        \
            if (SAMPLE) (XV)[jj] = (i < 15) ? *(const f32x2*)(past + (size_t)i * D + c0) : *(const f32x2*)(xrow0 + (size_t)(i - 15) * D + c0); \
            else { const int t = t0 - 15 + i; (XV)[jj] = *(const f32x2*)(xrow0 + (size_t)(t >= 0 ? t : 0) * D + c0); } } } while (0)
    f32x2 xa[16], xb[16]; POOL_LOAD(0, xa);
#pragma unroll
    for (int blk = 0; blk < NBLK; ++blk) {
        if (blk + 1 < NBLK) { if (blk & 1) POOL_LOAD(blk + 1, xa); else POOL_LOAD(blk + 1, xb); }
        const f32x2 (&xv)[16] = (blk & 1) ? xb : xa;
#pragma unroll
        for (int jj = 0; jj < 16; ++jj) { const int i = blk * 16 + jj;
            if (i < NTOT) {
                float h0 = 0.f, h1 = 0.f;
                if (SAMPLE) { if (i < 15) { h0 = xv[jj].x; h1 = xv[jj].y; } else { const float r = rinv_l[i - 15]; h0 = xv[jj].x * r * G0 + sh0; h1 = xv[jj].y * r * G1 + sh1; } }
                else { const int t = t0 - 15 + i; if (t >= 0) { const float r = rinv_l[i]; h0 = xv[jj].x * r * G0 + sh0; h1 = xv[jj].y * r * G1 + sh1; } }
                const int slot = i % W;
                s0 += h0 - r0[slot]; r0[slot] = h0; s1 += h1 - r1[slot]; r1[slot] = h1;
                if (i >= 15) {
                    const int tn = i - 15;
                    float cnt = (float)W;
                    if (!SAMPLE) { const int t = t0 + tn; cnt = (float)(t + 1 < W ? t + 1 : W); }
                    const float ic = 1.0f / cnt;
                    *(unsigned*)(drow0 + (size_t)tn * D + c0) = pk2(s0 * ic - h0, s1 * ic - h1);
                    if (SAMPLE) { if (st_out) *(f32x2*)(st_out + (size_t)(11 + tn) * D + c0) = (f32x2){h0, h1}; }
                    else if (st_out) { const int t = t0 + tn; if (t >= st_first) *(f32x2*)(st_out + (size_t)(t - st_first) * D + c0) = (f32x2){h0, h1}; }
                } else if (SAMPLE) {
                    if (st_out && i >= 4) *(f32x2*)(st_out + (size_t)(i - 4) * D + c0) = (f32x2){h0, h1};
                }
            } }
    }
}
__device__ __forceinline__ float row_sumsq(const float* xr, int lane) {
    float s = 0.f;
#pragma unroll
    for (int j = 0; j < 4; ++j) { const f32x4 v = *(const f32x4*)(xr + 4 * lane + 256 * j); s += (v[0] * v[0] + v[1] * v[1]) + (v[2] * v[2] + v[3] * v[3]); }
    return wave_sum(s);
}
#undef POOL_LOAD
__device__ __forceinline__ void pool_diff_phase(Frame& F, int l, int j, const float* xp, const float* xs  , const float* rs  , bool bal  ) {
    LAS float* rinv_l = (LAS float*)(F.lds + RING_OFF);
    const float* mod = WSP(float, WS_MOD);
    bf16* dp = WSP(bf16, WS_DP);
    const int c0 = 2 * F.tid, grp = F.tid >> 7;
    const float ng0 = F.inp(12)[(l * 2 + 0) * D + c0], ng1 = F.inp(12)[(l * 2 + 0) * D + c0 + 1];
    const int nu = bal ? (F.bid < 110 ? 0 : (F.bid < 220 ? 2 : 1)) : (NBP * 32 - F.bid + F.G - 1) / F.G;
    for (int ku = 0; ku < nu; ++ku) {
        const int uidx = bal ? (ku == 0 ? F.bid : F.bid - 110) : F.bid + ku * F.G;
        const int b = uidx >> 5, ch = uidx & 31, t0 = 64 * ch;
        const float* xseq = xp + (size_t)b * TP * D;
        const bool ride = (F.G == 256); const CpBase cpb = copy_base(F, 512u + (unsigned)uidx); f32x4 cpv[8];
        if (ride) { asm volatile("" : "+v"(F.tid)); RIDE_LOAD(8, cpv, cpb, j * 8192); }
        LDS_BARRIER();
        if (rs) { if (F.tid < 79) { const int t = t0 - 15 + F.tid; rinv_l[F.tid] = t >= 0 ? __builtin_amdgcn_rsqf(rs[(size_t)b * TP + t] * (1.0f / D) + EPS) : 0.f; } }
        else {
#pragma unroll
            for (int hf = 0; hf < 2; ++hf) {
                f32x4 xr[5][4];
#pragma unroll
                for (int k = 0; k < 5; ++k) { const int i = F.wave + 8 * (5 * hf + k), ic = i < 79 ? i : 78, t = t0 - 15 + ic; const float* xrp = xseq + (size_t)(t >= 0 ? t : 0) * D + 4 * F.lane;
#pragma unroll
                    for (int q = 0; q < 4; ++q) xr[k][q] = *(const f32x4*)(xrp + 256 * q); }
#pragma unroll
                for (int k = 0; k < 5; ++k) { const int i = F.wave + 8 * (5 * hf + k), t = t0 - 15 + i; float sq = 0.f;
#pragma unroll
                    for (int q = 0; q < 4; ++q) { const f32x4 v = xr[k][q]; sq += (v[0] * v[0] + v[1] * v[1]) + (v[2] * v[2] + v[3] * v[3]); }
                    sq = wave_sum(sq);
                    const float r = t >= 0 ? __builtin_amdgcn_rsqf(sq * (1.0f / D) + EPS) : 0.f;
                    if (F.lane == 0 && i < 79) rinv_l[i] = r; }
            }
        }
        LDS_BARRIER();
        if (ride) { asm volatile("" : "+v"(F.tid)); RIDE_STORE(8, cpv, cpb, j * 8192); asm volatile("" : "+v"(F.tid)); RIDE_LOAD(8, cpv, cpb, j * 8192 + 4096); }
        const float* mrow = mod + (size_t)b * MODLD + l * 6144;
        const float G0 = ng0 * (1.0f + mrow[1024 + c0]), G1 = ng1 * (1.0f + mrow[1024 + c0 + 1]), sh0 = mrow[c0], sh1 = mrow[c0 + 1];
        bf16* drow0 = dp + ((size_t)b * TP + t0) * D;
        float* st = (ch == 31) ? F_OUT + O_POOLP + ((size_t)j * NBP + b) * 15 * D : nullptr;
        if (grp == 0)      pool_march<2, 64, false>(xseq, t0, nullptr, rinv_l, c0, G0, G1, sh0, sh1, drow0, st, TP - 15);
        else if (grp == 1) pool_march<4, 64, false>(xseq, t0, nullptr, rinv_l, c0, G0, G1, sh0, sh1, drow0, st, TP - 15);
        else if (grp == 2) pool_march<8, 64, false>(xseq, t0, nullptr, rinv_l, c0, G0, G1, sh0, sh1, drow0, st, TP - 15);
        else               pool_march<16, 64, false>(xseq, t0, nullptr, rinv_l, c0, G0, G1, sh0, sh1, drow0, st, TP - 15);
        if (ride) { asm volatile("" : "+v"(F.tid)); RIDE_STORE(8, cpv, cpb, j * 8192 + 4096); }
    }
    for (int b = bal ? (F.bid < 110 ? F.bid : (F.bid >= 220 && F.bid < 238 ? F.bid - 110 : -1)) : (F.G >= 2 * NBS ? F.bid - NBS : F.bid); b < NBS; b += F.G) {
        if (b < 0) continue;
        const float* xrow0 = xs + ((size_t)MP + 4 * b) * D;
        __syncthreads();
        if (rs) { if (F.tid < 4) rinv_l[F.tid] = __builtin_amdgcn_rsqf(rs[(size_t)MP + 4 * b + F.tid] * (1.0f / D) + EPS); }
        else if (F.wave < 4) { const float r = __builtin_amdgcn_rsqf(row_sumsq(xrow0 + (size_t)F.wave * D, F.lane) * (1.0f / D) + EPS); if (F.lane == 0) rinv_l[F.wave] = r; }
        __syncthreads();
        const float* mrow = mod + (size_t)(NBP + b) * MODLD + l * 6144;
        const float G0 = ng0 * (1.0f + mrow[1024 + c0]), G1 = ng1 * (1.0f + mrow[1024 + c0 + 1]), sh0 = mrow[c0], sh1 = mrow[c0 + 1];
        const float* past = F.inp(2) + ((size_t)j * NBS + b) * 15 * D;
        bf16* drow0 = dp + ((size_t)MP + 4 * b) * D;
        float* st = F_OUT + O_POOLS + ((size_t)j * NBS + b) * 15 * D;
        if (grp == 0)      pool_march<2, 4, true>(xrow0, 0, past, rinv_l, c0, G0, G1, sh0, sh1, drow0, st, 0);
        else if (grp == 1) pool_march<4, 4, true>(xrow0, 0, past, rinv_l, c0, G0, G1, sh0, sh1, drow0, st, 0);
        else if (grp == 2) pool_march<8, 4, true>(xrow0, 0, past, rinv_l, c0, G0, G1, sh0, sh1, drow0, st, 0);
        else               pool_march<16, 4, true>(xrow0, 0, past, rinv_l, c0, G0, G1, sh0, sh1, drow0, st, 0);
    }
}

__device__ __forceinline__ void ffn_fixup_phase(Frame& F, int l) {
    const float* hg = WSP(float, WS_HG); const float* hu = WSP(float, WS_HU); const float* tg = WSP(float, WS_TG);
    bf16* act = WSP(bf16, WS_ACT);
    const float* cw = F.inp(25) + (size_t)l * 3 * DFF; const float* cbv = F.inp(26) + (size_t)l * DFF;
    for (int s = F.bid; s < 256; s += F.G) {
        const bool first = (s & 31) == 0;
        const size_t sp = (size_t)(first ? s : s - 1);
        float gm2[6], gm1[6], g0[6], g1[6], u0[6], u1[6], w0[6], w1[6], w2[6], bb[6];
#pragma unroll
        for (int k = 0; k < 6; ++k) { const int colr = F.tid + 512 * k, col = colr < DFF ? colr : DFF - 1;
            gm2[k] = tg[(sp * 2 + 0) * DFF + col]; gm1[k] = tg[(sp * 2 + 1) * DFF + col];
            g0[k] = hg[((size_t)s * 2 + 0) * DFF + col]; g1[k] = hg[((size_t)s * 2 + 1) * DFF + col];
            u0[k] = hu[((size_t)s * 2 + 0) * DFF + col]; u1[k] = hu[((size_t)s * 2 + 1) * DFF + col];
            w0[k] = cw[col]; w1[k] = cw[DFF + col]; w2[k] = cw[2 * DFF + col]; bb[k] = cbv[col]; }
#pragma unroll
        for (int k = 0; k < 6; ++k) { const int col = F.tid + 512 * k;
            const float m2 = first ? 0.f : gm2[k], m1 = first ? 0.f : gm1[k];
            const float a0 = pg8::gelu1(w0[k] * m2 + w1[k] * m1 + w2[k] * g0[k] + bb[k]) * u0[k];
            const float a1 = pg8::gelu1(w0[k] * m1 + w1[k] * g0[k] + w2[k] * g1[k] + bb[k]) * u1[k];
            if (col < DFF) { act[(size_t)(64 * s) * DFF + col] = (bf16)(pk2(a0, 0.f) & 0xffffu); act[(size_t)(64 * s + 1) * DFF + col] = (bf16)(pk2(a1, 0.f) & 0xffffu); } }
    }
}


__device__ __forceinline__ int t5_bucket(int dist) {
    if (dist < 16) return dist;
    const float df = (float)dist;
    int large = 16 + (int)(logf(df / 16.0f) / 4.852030263919617f * 16.0f);
    return large < 31 ? large : 31;
}
__device__ __forceinline__ void attn_block(Frame& F, int b, int hs, int g, int rho, int d, int i0) {
    LAS bf16* Ks = (LAS bf16*)(F.lds + RING_OFF);
    LAS bf16* Vt = (LAS bf16*)(F.lds + RING_OFF + 36864);
    const LAS float* bias_l = (const LAS float*)(F.lds + RING_OFF + 72704) + (g * 4 + hs) * 132;
    const bf16* QB = WSP(bf16, WS_QB); const bf16* KB = WSP(bf16, WS_KB); const bf16* VB = WSP(bf16, WS_VB);
    bf16* AO = WSP(bf16, WS_AO); float* LSE = WSP(float, WS_LSE);
    const int colq = g * 256 + hs * 64;
    const int fr = F.lane & 15, fq = F.lane >> 4;
#pragma unroll
    for (int j = 0; j < 4; ++j) {
        const int id = F.tid + 512 * j, key = id >> 3, part = id & 7, ki = i0 - 128 + key;
        v4u kv = {0u, 0u, 0u, 0u}, vv = {0u, 0u, 0u, 0u};
        if (ki >= 0) { const size_t row = (size_t)b * TP + rho + d * ki; kv = *(const v4u*)(KB + row * 768 + colq + part * 8); vv = *(const v4u*)(VB + row * 768 + colq + part * 8); }
        *(LAS v4u*)(Ks + key * 72 + part * 8) = kv;
        LAS bf16* vt = Vt + (part * 8) * 264 + key;
        vt[0 * 264] = (bf16)(vv.x & 0xffffu); vt[1 * 264] = (bf16)(vv.x >> 16); vt[2 * 264] = (bf16)(vv.y & 0xffffu); vt[3 * 264] = (bf16)(vv.y >> 16);
        vt[4 * 264] = (bf16)(vv.z & 0xffffu); vt[5 * 264] = (bf16)(vv.z >> 16); vt[6 * 264] = (bf16)(vv.w & 0xffffu); vt[7 * 264] = (bf16)(vv.w >> 16);
    }
    __syncthreads();
    const int w = F.wave, ql = 16 * w + fr;
    const size_t rowq = (size_t)b * TP + rho + d * (i0 + ql);
    bf16x8 qf[2];
    qf[0] = *(const bf16x8*)(QB + rowq * 768 + colq + 8 * fq); qf[1] = *(const bf16x8*)(QB + rowq * 768 + colq + 32 + 8 * fq);
    float sc[9][4]; float mx = -1e30f;
#pragma unroll
    for (int jt = 0; jt < 9; ++jt) {
        const int tile = w + jt;
        f32x4 acc = {0.f, 0.f, 0.f, 0.f};
#pragma unroll
        for (int s = 0; s < 2; ++s) { const bf16x8 a = *(const LAS bf16x8*)(Ks + (16 * tile + fr) * 72 + 32 * s + 8 * fq); acc = MFMA16(a, qf[s], acc); }
#pragma unroll
        for (int j = 0; j < 4; ++j) { const int kl = 16 * tile + 4 * fq + j, dist = ql + 128 - kl; const bool valid = dist >= 0 && dist <= 128 && (i0 - 128 + kl) >= 0;
            const float v = valid ? acc[j] + bias_l[valid ? dist : 0] : -1e30f; sc[jt][j] = v; mx = v > mx ? v : mx; }
    }
    { const float o1 = __shfl_xor(mx, 16); mx = o1 > mx ? o1 : mx; const float o2 = __shfl_xor(mx, 32); mx = o2 > mx ? o2 : mx; }
    float sum = 0.f;
#pragma unroll
    for (int jt = 0; jt < 9; ++jt)
#pragma unroll
        for (int j = 0; j < 4; ++j) { const float e = __expf(sc[jt][j] - mx); sc[jt][j] = e; sum += e; }
    sum += __shfl_xor(sum, 16); sum += __shfl_xor(sum, 32);
    const float inv = 1.0f / sum, lse = mx + __logf(sum);
    f32x4 o[4];
#pragma unroll
    for (int db = 0; db < 4; ++db) o[db] = (f32x4){0.f, 0.f, 0.f, 0.f};
#pragma unroll
    for (int pp = 0; pp < 5; ++pp) {
        const int ta = w + 2 * pp, tb = ta + 1; const bool hasb = (2 * pp + 1) < 9;
        v4u pb; pb.x = pk2(sc[2 * pp][0] * inv, sc[2 * pp][1] * inv); pb.y = pk2(sc[2 * pp][2] * inv, sc[2 * pp][3] * inv);
        if (hasb) { pb.z = pk2(sc[hasb ? 2 * pp + 1 : 0][0] * inv, sc[hasb ? 2 * pp + 1 : 0][1] * inv); pb.w = pk2(sc[hasb ? 2 * pp + 1 : 0][2] * inv, sc[hasb ? 2 * pp + 1 : 0][3] * inv); } else { pb.z = 0u; pb.w = 0u; }
        const bf16x8 pB = __builtin_bit_cast(bf16x8, pb);
#pragma unroll
        for (int db = 0; db < 4; ++db) {
            const LAS bf16* vr = Vt + (16 * db + fr) * 264 + 4 * fq;
            const v2u lo = *(const LAS v2u*)(vr + 16 * ta); v2u hi = {0u, 0u}; if (hasb) hi = *(const LAS v2u*)(vr + 16 * tb);
            const v4u av = {lo.x, lo.y, hi.x, hi.y};
            o[db] = MFMA16(__builtin_bit_cast(bf16x8, av), pB, o[db]);
        }
    }
#pragma unroll
    for (int db = 0; db < 4; ++db) { v2u ov; ov.x = pk2(o[db][0], o[db][1]); ov.y = pk2(o[db][2], o[db][3]); *(v2u*)(AO + rowq * 768 + colq + 16 * db + 4 * fq) = ov; }
    if (fq == 0) LSE[rowq * 12 + g * 4 + hs] = lse;
    __syncthreads();
}
__device__ __forceinline__ void attn_sample_task(Frame& F, int G, int tok, int hs, LAS float* sc_l, const LAS float* bias_t) {
    const int d = 1 << (2 * G), W = 128 << (2 * G);
    const float* cache = F.inp(3 + G);
    const bf16* QB = WSP(bf16, WS_QB); const bf16* KB = WSP(bf16, WS_KB); const bf16* VB = WSP(bf16, WS_VB);
    bf16* AO = WSP(bf16, WS_AO); float* LSE = WSP(float, WS_LSE);
    const int b = tok >> 2, t = tok & 3;
    const int kq = F.lane >> 4, dl = F.lane & 15, colq = G * 256 + hs * 64;
    const size_t rowq = (size_t)MP + tok;
    f32x4 q4; { const v2u qw = *(const v2u*)(QB + rowq * 768 + colq + 4 * dl); q4 = (f32x4){bflo(qw.x), bfhi(qw.x), bflo(qw.y), bfhi(qw.y)}; }
    const float* crow = cache + ((size_t)b * W - (size_t)(TP - W)) * 512 + hs * 64 + 4 * dl;
    f32x4 kk[33];
    { const int pos = TP + t - kq * d;
      if (pos >= TP) { const v2u kw = *(const v2u*)(KB + ((size_t)MP + 4 * b + (pos - TP)) * 768 + colq + 4 * dl); kk[0] = (f32x4){bflo(kw.x), bfhi(kw.x), bflo(kw.y), bfhi(kw.y)}; }
      else kk[0] = *(const f32x4*)(crow + (size_t)pos * 512); }
    const float* krow = crow + (size_t)(TP + t - kq * d) * 512;
#pragma unroll
    for (int it = 1; it < 32; ++it) kk[it] = *(const f32x4*)(krow - (size_t)it * (size_t)(2048 * d));
    kk[32] = *(const f32x4*)(crow + (size_t)(TP + t - 128 * d) * 512);
    float mx = -1e30f;
    const LAS float* bias_j = bias_t + (G * 4 + hs) * 132 + kq;
#pragma unroll
    for (int it = 0; it < 33; ++it) {
        float s = (q4[0] * kk[it][0] + q4[1] * kk[it][1]) + (q4[2] * kk[it][2] + q4[3] * kk[it][3]);
        s += __shfl_xor(s, 1); s += __shfl_xor(s, 2); s += __shfl_xor(s, 4); s += __shfl_xor(s, 8);
        if (it < 32) { s += bias_j[4 * it]; mx = s > mx ? s : mx; if (dl == 0) sc_l[4 * it + kq] = s; }
        else if (kq == 0) { s += bias_j[128]; mx = s > mx ? s : mx; if (dl == 0) sc_l[128] = s; }
    }
    { const float o1 = __shfl_xor(mx, 16); mx = o1 > mx ? o1 : mx; const float o2 = __shfl_xor(mx, 32); mx = o2 > mx ? o2 : mx; }
    asm volatile("" ::: "memory");
    f32x4 vv[33];
    { const int pos = TP + t - kq * d;
      if (pos >= TP) { const v2u vw = *(const v2u*)(VB + ((size_t)MP + 4 * b + (pos - TP)) * 768 + colq + 4 * dl); vv[0] = (f32x4){bflo(vw.x), bfhi(vw.x), bflo(vw.y), bfhi(vw.y)}; }
      else vv[0] = *(const f32x4*)(crow + (size_t)pos * 512 + 256); }
#pragma unroll
    for (int it = 1; it < 32; ++it) vv[it] = *(const f32x4*)(krow - (size_t)it * (size_t)(2048 * d) + 256);
    vv[32] = *(const f32x4*)(crow + (size_t)(TP + t - 128 * d) * 512 + 256);
    LDS_WAIT(); asm volatile("" ::: "memory");
    float sum = 0.f; f32x4 o = {0.f, 0.f, 0.f, 0.f};
#pragma unroll
    for (int it = 0; it < 33; ++it) {
        float e = __expf(sc_l[it < 32 ? 4 * it + kq : 128] - mx); if (it == 32 && kq != 0) e = 0.f;
        sum += e; o += vv[it] * e;
    }
    sum += __shfl_xor(sum, 16); sum += __shfl_xor(sum, 32);
#pragma unroll
    for (int e = 0; e < 4; ++e) { o[e] += __shfl_xor(o[e], 16); o[e] += __shfl_xor(o[e], 32); }
    const float inv = 1.0f / sum, lse = mx + __logf(sum);
    if (kq == 0) { v2u ov; ov.x = pk2(o[0] * inv, o[1] * inv); ov.y = pk2(o[2] * inv, o[3] * inv); *(v2u*)(AO + rowq * 768 + colq + 4 * dl) = ov; }
    if (F.lane == 0) LSE[rowq * 12 + G * 4 + hs] = lse;
    LDS_WAIT(); asm volatile("" ::: "memory");
}
constexpr unsigned CP_SLICE = 16384u, CP_NSLICES = 128u * 16u + 128u * 4u + 128u;
constexpr int CW_CPHEAD = 8192;
__device__ __forceinline__ void copy_slice(Frame& F, unsigned s) {
    const f32x4* src; f32x4* dst; unsigned per_b, k;
    if (s < 2048u) { const unsigned b = s >> 4; k = s & 15u; per_b = 2044u * 128u; src = (const f32x4*)F.inp(5) + (size_t)b * (2048 * 128) + 512; dst = (f32x4*)(F_OUT + O_W3S) + (size_t)b * (2048 * 128); }
    else if (s < 2560u) { const unsigned q = s - 2048u, b = q >> 2; k = q & 3u; per_b = 508u * 128u; src = (const f32x4*)F.inp(4) + (size_t)b * (512 * 128) + 512; dst = (f32x4*)(F_OUT + O_W2S) + (size_t)b * (512 * 128); }
    else { const unsigned b = s - 2560u; k = 0u; per_b = 124u * 128u; src = (const f32x4*)F.inp(3) + (size_t)b * (128 * 128) + 512; dst = (f32x4*)(F_OUT + O_W1S) + (size_t)b * (128 * 128); }
    const unsigned base = k * CP_SLICE + F.tid;
#pragma unroll 1
    for (int bt = 0; bt < 2; ++bt) {
        f32x4 v[16];
#pragma unroll
        for (int u = 0; u < 16; ++u) { const unsigned i = base + (unsigned)(bt * 16 + u) * 512u; if (i < per_b) v[u] = __builtin_nontemporal_load(src + i); }
#pragma unroll
        for (int u = 0; u < 16; ++u) { const unsigned i = base + (unsigned)(bt * 16 + u) * 512u; if (i < per_b) __builtin_nontemporal_store(v[u], dst + i); }
    }
}
__device__ __forceinline__ void copy_pull(Frame& F, int n) {
    LAS unsigned* sh = (LAS unsigned*)(F.lds + MISC_OFF) + 16;
    unsigned* head = (unsigned*)(F_WS + WS_CTL) + CW_CPHEAD;
    for (;;) {
        const int take = n > 0 ? n : 2;
        LDS_BARRIER();
        if (F.tid == 0) *sh = __hip_atomic_fetch_add(head, (unsigned)take, __ATOMIC_RELAXED, __HIP_MEMORY_SCOPE_AGENT);
        LDS_BARRIER();
        const unsigned s0 = *sh + (F.G == 256 ? CP_NSTATIC : 0u);
        if (s0 >= CP_NSLICES) break;
        for (unsigned s = s0; s < s0 + (unsigned)take && s < CP_NSLICES; ++s) copy_slice(F, s);
        if (n > 0) break;
    }
}
__device__ __forceinline__ void attn_phase(Frame& F) {
    { LAS float* bt = (LAS float*)(F.lds + RING_OFF + 72704);
      for (int i = F.tid; i < 12 * 129; i += 512) { const int hd = i / 129, j = i % 129; bt[hd * 132 + j] = F.inp(14)[t5_bucket(j << (2 * (hd >> 2))) * 12 + hd]; }
      __syncthreads(); }
    const int vcu = (F.G % 8 == 0) ? (F.bid % 8) * (F.G / 8) + F.bid / 8 : F.bid;
    for (int idx = vcu; idx < 1536; idx += F.G) {
        const int b = idx / 192, r = idx % 192, hs = r / 48, r2 = r % 48, g = r2 / 16, sub = r2 % 16;
        const int d = 1 << (2 * g), rho = g == 0 ? 0 : (g == 1 ? (sub >> 2) : sub), i0 = g == 0 ? 128 * sub : (g == 1 ? 128 * (sub & 3) : 0);
        const int it = (idx - vcu) / F.G; const bool ride = (F.G == 256) && it < 6;
        const CpBase cpb = copy_base(F, it < 4 ? (unsigned)F.bid : 1024u + ((unsigned)F.bid >> 1)); const int e0 = it < 4 ? it * 4096 : (F.bid & 1) * 8192 + (it - 4) * 4096;
        f32x4 cpv[8];
        if (ride) RIDE_LOAD(8, cpv, cpb, e0);
        attn_block(F, b, hs, g, rho, d, i0);
        if (ride) RIDE_STORE(8, cpv, cpb, e0);
    }
    LAS float* sc_l = (LAS float*)(F.lds + RING_OFF) + F.wave * 160; const LAS float* bias_t = (const LAS float*)(F.lds + RING_OFF + 72704);
    const int gw = F.bid * NWAVES + F.wave, ngw = F.G * NWAVES;
    for (int task = gw; task < MS * 12; task += ngw) attn_sample_task(F, task / (MS * 4), (task % (MS * 4)) >> 2, task & 3, sc_l, bias_t);
}
__device__ __forceinline__ void attn_merge_phase(Frame& F) {
    bf16* AO = WSP(bf16, WS_AO); const float* LSE = WSP(float, WS_LSE);
    const size_t nt = (size_t)F.G * 512;
    for (size_t i0 = (size_t)F.bid * 512 + F.tid; i0 < (size_t)M * 96; i0 += 8 * nt) {
        v4u w[8]; float l0[8], l1[8], l2[8];
#pragma unroll
        for (int u = 0; u < 8; ++u) { const size_t i = i0 + u * nt < (size_t)M * 96 ? i0 + u * nt : i0; const size_t row = i / 96; const int col = (int)(i % 96) * 8, hs = (col & 255) >> 6;
            w[u] = *(const v4u*)(AO + row * 768 + col); l0[u] = LSE[row * 12 + hs]; l1[u] = LSE[row * 12 + 4 + hs]; l2[u] = LSE[row * 12 + 8 + hs]; }
#pragma unroll
        for (int u = 0; u < 8; ++u) { const size_t i = i0 + u * nt; if (i < (size_t)M * 96) { const size_t row = i / 96; const int col = (int)(i % 96) * 8, g = col >> 8;
            const float mx = fmaxf(l0[u], fmaxf(l1[u], l2[u])), e0 = __expf(l0[u] - mx), e1 = __expf(l1[u] - mx), e2 = __expf(l2[u] - mx);
            const float al = (g == 0 ? e0 : (g == 1 ? e1 : e2)) / (e0 + e1 + e2);
            v4u o; o.x = pk2(bflo(w[u].x) * al, bfhi(w[u].x) * al); o.y = pk2(bflo(w[u].y) * al, bfhi(w[u].y) * al); o.z = pk2(bflo(w[u].z) * al, bfhi(w[u].z) * al); o.w = pk2(bflo(w[u].w) * al, bfhi(w[u].w) * al);
            *(v4u*)(AO + row * 768 + col) = o; } }
    }
}

__device__ __forceinline__ void rider_res(Frame& F, const pg8::Gemm g, const pg8::EpiRes E) {
    LAS float* part = (LAS float*)(F.lds + RING_OFF);
    const int fr = F.lane & 15, fq = F.lane >> 4, w = F.wave;
    const int kw = g.K >> 3, nks = kw >> 5;
    for (int piece = F.bid; piece < 256; piece += F.G) {
        const int rg = piece >> 4, cg = piece & 15;
        const bf16* Ab = g.A + (size_t)(MP + 32 * rg + fr) * g.lda + (size_t)g.a_pn * (cg >> 2) + (size_t)w * kw + 8 * fq;
        const bf16* Bb = g.Bt + (size_t)(64 * cg + fr) * g.ldb + (size_t)w * kw + 8 * fq;
        f32x4 acc[2][4];
#pragma unroll
        for (int rb = 0; rb < 2; ++rb)
#pragma unroll
            for (int cb = 0; cb < 4; ++cb) acc[rb][cb] = (f32x4){0.f, 0.f, 0.f, 0.f};
        for (int ks0 = 0; ks0 < nks; ks0 += 4) {
            bf16x8 a[4][2], b[4][4];
#pragma unroll
            for (int i = 0; i < 4; ++i) { const int ks = (ks0 + i < nks) ? ks0 + i : nks - 1;
#pragma unroll
                for (int rb = 0; rb < 2; ++rb) a[i][rb] = *(const bf16x8*)(Ab + (size_t)(16 * rb) * g.lda + 32 * ks);
#pragma unroll
                for (int cb = 0; cb < 4; ++cb) b[i][cb] = *(const bf16x8*)(Bb + (size_t)(16 * cb) * g.ldb + 32 * ks); }
#pragma unroll
            for (int i = 0; i < 4; ++i) if (ks0 + i < nks) {
#pragma unroll
                for (int rb = 0; rb < 2; ++rb)
#pragma unroll
                    for (int cb = 0; cb < 4; ++cb) acc[rb][cb] = MFMA16(a[i][rb], b[i][cb], acc[rb][cb]); }
        }
        __syncthreads();
#pragma unroll
        for (int rb = 0; rb < 2; ++rb)
#pragma unroll
            for (int cb = 0; cb < 4; ++cb) *(LAS f32x4*)(part + ((w * 8 + rb * 4 + cb) * 64 + F.lane) * 4) = acc[rb][cb];
        __syncthreads();
        const int rb = w >> 2, cb = w & 3;
        f32x4 v = {0.f, 0.f, 0.f, 0.f};
#pragma unroll
        for (int ww = 0; ww < 8; ++ww) v += *(const LAS f32x4*)(part + ((ww * 8 + w) * 64 + F.lane) * 4);
        const int col = 64 * cg + 16 * cb + fr;
        const float ps = E.pscale ? E.pscale[col] : 1.0f, ng = E.ngain ? E.ngain[col] : 0.f;
#pragma unroll
        for (int j = 0; j < 4; ++j) {
            const int rl = 16 * rb + 4 * fq + j, row = MP + 32 * rg + rl, bi = NBP + ((row - MP) >> 2);
            const float xn = E.xin_s[(size_t)row * D + col] + E.gate[(size_t)bi * MODLD + col] * ps * v[j];
            E.xout[(size_t)row * D + col] = xn;
            if (E.ngain) E.an[(size_t)row * D + col] = (bf16)(pk2(xn * (ng * (1.0f + E.nscale[(size_t)bi * MODLD + col])), 0.f) & 0xffffu);
            float ss = xn * xn;
            ss += __shfl_xor(ss, 1); ss += __shfl_xor(ss, 2); ss += __shfl_xor(ss, 4); ss += __shfl_xor(ss, 8);
            if (fr == 0) atomicAdd(E.rss + row, ss);
        }
    }
}

__device__ __forceinline__ float log_sigmoid(float z) { return fminf(z, 0.f) - log1pf(__expf(-fabsf(z))); }
__device__ __forceinline__ float log_sigmoid_fast(float z) { return fminf(z, 0.f) - __logf(1.0f + __expf(-fabsf(z))); }
__device__ __forceinline__ void gla_prep_phase(Frame& F) {
    LAS bf16* Qd_l = (LAS bf16*)(F.lds + RING_OFF);
    LAS bf16* Kd_l = (LAS bf16*)(F.lds + RING_OFF + 66560);
    const bf16* GQ = WSP(bf16, WS_GQ); const bf16* GK = WSP(bf16, WS_GK); const float* GD = WSP(float, WS_GD);
    bf16* QD = WSP(bf16, WS_QD); bf16* KET = WSP(bf16, WS_KET); bf16* ATT = WSP(bf16, WS_ATT); float* DEC = WSP(float, WS_DEC);
    const int col = F.tid;
    float wg[16];
#pragma unroll
    for (int j = 0; j < 16; ++j) wg[j] = F.inp(20)[j * 512 + col];
    const float bg = F.inp(21)[col];
    for (int cidx = F.bid; cidx < NBP * 32; cidx += F.G) {
        const size_t r0 = (size_t)cidx * 64;
        __syncthreads();
        float bc = 0.f;
        const bool ride = (F.G == 256) && cidx == F.bid; const CpBase cpb = copy_base(F, 256u + (unsigned)F.bid);
#define PREP_LOAD(S8, QV, KV, ZZ) do { \
            _Pragma("unroll") for (int e = 0; e < 8; ++e) { (QV)[e] = GQ[(r0 + 8 * (S8) + e) * 512 + col]; (KV)[e] = GK[(r0 + 8 * (S8) + e) * 512 + col]; } \
            _Pragma("unroll") for (int e = 0; e < 8; ++e) { const float* gd = GD + (r0 + 8 * (S8) + e) * 16; float z = bg; \
                _Pragma("unroll") for (int j = 0; j < 16; ++j) z += gd[j] * wg[j]; \
                (ZZ)[e] = z; } } while (0)
#define PREP_STEP(S8, QV, KV, ZZ) do { _Pragma("unroll") for (int e = 0; e < 8; ++e) { const int s = 8 * (S8) + e; \
                bc += log_sigmoid_fast((ZZ)[e]) * 0.0625f; \
                const float eb = __expf(bc), ieb = __builtin_amdgcn_rcpf(eb); \
                const unsigned qd = pk2(bf2f((QV)[e]) * eb, 0.f) & 0xffffu, kd = pk2(bf2f((KV)[e]) * ieb, 0.f) & 0xffffu; \
                QD[(r0 + s) * 512 + col] = (bf16)qd; Qd_l[s * 520 + col] = (bf16)qd; Kd_l[s * 520 + col] = (bf16)kd; } } while (0)
        unsigned short qa[8], ka[8], qb[8], kb[8]; float za[8], zb[8];
        PREP_LOAD(0, qa, ka, za);
#pragma unroll 1
        for (int s8 = 0; s8 < 8; s8 += 2) {
            f32x4 cpv[4];
            if (ride) RIDE_LOAD(4, cpv, cpb, s8 * 2048);
            PREP_LOAD(s8 + 1, qb, kb, zb);
            PREP_STEP(s8, qa, ka, za);
            if (ride) { RIDE_STORE(4, cpv, cpb, s8 * 2048); RIDE_LOAD(4, cpv, cpb, (s8 + 1) * 2048); }
            { const int s8n = s8 + 2 < 8 ? s8 + 2 : 7; PREP_LOAD(s8n, qa, ka, za); }
            PREP_STEP(s8 + 1, qb, kb, zb);
            if (ride) RIDE_STORE(4, cpv, cpb, (s8 + 1) * 2048);
        }
#undef PREP_STEP
#undef PREP_LOAD
        const float dec = __expf(bc);
        DEC[(size_t)cidx * 512 + col] = dec;
#pragma unroll
        for (int s8 = 0; s8 < 8; ++s8) {
            float ke[8];
#pragma unroll
            for (int e = 0; e < 8; ++e) ke[e] = bf2f(Kd_l[(8 * s8 + e) * 520 + col]) * dec;
            v4u w; w.x = pk2(ke[0], ke[1]); w.y = pk2(ke[2], ke[3]); w.z = pk2(ke[4], ke[5]); w.w = pk2(ke[6], ke[7]);
            *(v4u*)(KET + ((size_t)cidx * 512 + col) * 64 + 8 * s8) = w;
        }
        __syncthreads();
        int ln_ = F.lane; asm volatile("" : "+v"(ln_));
        const int fr = ln_ & 15, fq = ln_ >> 4;
        const int h = F.wave >> 1;
#pragma unroll
        for (int i = 0; i < 8; ++i) {
            const int sb = (F.wave & 1) * 2 + (i >> 2), tb = i & 3;
            f32x4 acc = {0.f, 0.f, 0.f, 0.f};
#pragma unroll
            for (int ks = 0; ks < 4; ++ks) {
                const bf16x8 a = *(const LAS bf16x8*)(Kd_l + (16 * sb + fr) * 520 + h * 128 + 32 * ks + 8 * fq);
                const bf16x8 bq = *(const LAS bf16x8*)(Qd_l + (16 * tb + fr) * 520 + h * 128 + 32 * ks + 8 * fq);
                acc = MFMA16(a, bq, acc);
            }
            int t = 16 * tb + fr; const int s0 = 16 * sb + 4 * fq;
            asm volatile("" : "+v"(t));
            v2u o; o.x = pk2(s0 + 0 <= t ? acc[0] : 0.f, s0 + 1 <= t ? acc[1] : 0.f); o.y = pk2(s0 + 2 <= t ? acc[2] : 0.f, s0 + 3 <= t ? acc[3] : 0.f);
            *(v2u*)(ATT + (((size_t)cidx * 4 + h) * 64 + t) * 64 + s0) = o;
        }
    }
}
__device__ __forceinline__ void gla_scan_phase(Frame& F) {
    const bf16* QD = WSP(bf16, WS_QD); const bf16* KET = WSP(bf16, WS_KET); const bf16* ATT = WSP(bf16, WS_ATT); const float* DEC = WSP(float, WS_DEC);
    const bf16* GV = WSP(bf16, WS_GV); float* GO = WSP(float, WS_GO);
    const int fr = F.lane & 15, fq = F.lane >> 4, w = F.wave, tb = w >> 1, cbo = w & 1;
    const int vcu = (F.G % 8 == 0) ? (F.bid % 8) * (F.G / 8) + F.bid / 8 : F.bid;
    for (int chain = vcu; chain < 256; chain += F.G) {
        const int b = chain >> 5, h = (chain >> 3) & 3, vs = chain & 7;
        f32x4 S[2]; S[0] = (f32x4){0.f, 0.f, 0.f, 0.f}; S[1] = (f32x4){0.f, 0.f, 0.f, 0.f};
        __syncthreads();
        bf16x8 qd[3][4], at[3][2], ke[3][2]; f32x4 dc[3]; v2u vv[3];
        const bool ride = (F.G == 256) && chain == vcu; const CpBase cb0 = copy_base(F, 768u + (unsigned)F.bid); f32x4 cpa[3];
#define SCAN_LOAD(CH, SET) do { const size_t ci_ = (size_t)b * 32 + (CH), rr_ = ci_ * 64; \
            _Pragma("unroll") for (int ks = 0; ks < 4; ++ks) qd[SET][ks] = *(const bf16x8*)(QD + (rr_ + 16 * tb + fr) * 512 + h * 128 + 32 * ks + 8 * fq); \
            _Pragma("unroll") for (int ks = 0; ks < 2; ++ks) { at[SET][ks] = *(const bf16x8*)(ATT + ((ci_ * 4 + h) * 64 + 16 * tb + fr) * 64 + 32 * ks + 8 * fq); \
                                             ke[SET][ks] = *(const bf16x8*)(KET + (ci_ * 512 + h * 128 + 16 * w + fr) * 64 + 32 * ks + 8 * fq); } \
            dc[SET] = *(const f32x4*)(DEC + ci_ * 512 + h * 128 + 16 * w + 4 * fq); \
            vv[SET] = *(const v2u*)(GV + (rr_ + (F.tid >> 3)) * 1024 + h * 256 + vs * 32 + (F.tid & 7) * 4); \
            if (ride) { const unsigned e_ = (unsigned)(CH) * 512u + (unsigned)F.tid; cpa[SET] = __builtin_nontemporal_load(cb0.src + (e_ < cb0.n ? e_ : cb0.n - 1u)); } } while (0)
#define SCAN_STEP(CH, SET) do { const size_t r0_ = ((size_t)b * 32 + (CH)) * 64; \
            LAS bf16* Vt_l = (LAS bf16*)(F.lds + RING_OFF + ((CH) & 1) * 16384);              \
            LAS bf16* St_l = (LAS bf16*)(F.lds + RING_OFF + ((CH) & 1) * 16384 + 4608);       \
            { const int s_ = F.tid >> 3, c4 = (F.tid & 7) * 4; const v2u v_ = vv[SET]; \
              Vt_l[(c4 + 0) * 72 + s_] = (bf16)(v_.x & 0xffffu); Vt_l[(c4 + 1) * 72 + s_] = (bf16)(v_.x >> 16); Vt_l[(c4 + 2) * 72 + s_] = (bf16)(v_.y & 0xffffu); Vt_l[(c4 + 3) * 72 + s_] = (bf16)(v_.y >> 16); } \
            _Pragma("unroll") for (int cb = 0; cb < 2; ++cb) { v2u sv; sv.x = pk2(S[cb][0], S[cb][1]); sv.y = pk2(S[cb][2], S[cb][3]); *(LAS v2u*)(St_l + (16 * cb + fr) * 136 + 16 * w + 4 * fq) = sv; } \
            LDS_BARRIER(); \
            f32x4 o = {0.f, 0.f, 0.f, 0.f}; \
            _Pragma("unroll") for (int ks = 0; ks < 4; ++ks) { const bf16x8 bs = *(const LAS bf16x8*)(St_l + (16 * cbo + fr) * 136 + 32 * ks + 8 * fq); o = MFMA16(qd[SET][ks], bs, o); } \
            _Pragma("unroll") for (int ks = 0; ks < 2; ++ks) { const bf16x8 bv = *(const LAS bf16x8*)(Vt_l + (16 * cbo + fr) * 72 + 32 * ks + 8 * fq); o = MFMA16(at[SET][ks], bv, o); } \
            _Pragma("unroll") for (int cb = 0; cb < 2; ++cb) { S[cb] = S[cb] * dc[SET]; \
                _Pragma("unroll") for (int ks = 0; ks < 2; ++ks) { const bf16x8 bv = *(const LAS bf16x8*)(Vt_l + (16 * cb + fr) * 72 + 32 * ks + 8 * fq); S[cb] = MFMA16(ke[SET][ks], bv, S[cb]); } } \
            _Pragma("unroll") for (int j = 0; j < 4; ++j) GO[(r0_ + 16 * tb + 4 * fq + j) * 1024 + h * 256 + vs * 32 + 16 * cbo + fr] = o[j]; \
            if (ride) { const unsigned e_ = (unsigned)(CH) * 512u + (unsigned)F.tid; if (e_ < cb0.n) __builtin_nontemporal_store(cpa[SET], cb0.dst + e_); } } while (0)
        SCAN_LOAD(0, 0); SCAN_LOAD(1, 1);
#pragma unroll 1
        for (int ch = 0; ch < 30; ch += 3) {
            SCAN_LOAD(ch + 2, 2);      SCAN_STEP(ch, 0);
            SCAN_LOAD(ch + 3, 0);      SCAN_STEP(ch + 1, 1);
            SCAN_LOAD(ch + 4, 1);      SCAN_STEP(ch + 2, 2);
        }
        SCAN_STEP(30, 0); SCAN_STEP(31, 1);
#undef SCAN_LOAD
#undef SCAN_STEP
        float* so = F_OUT + O_GLAP + ((size_t)(b * 4 + h) * 128) * 256 + vs * 32;
#pragma unroll
        for (int cb = 0; cb < 2; ++cb)
#pragma unroll
            for (int j = 0; j < 4; ++j) so[(size_t)(16 * w + 4 * fq + j) * 256 + 16 * cb + fr] = S[cb][j];
    }
}
__device__ __forceinline__ void gla_sample_phase(Frame& F) {
    LAS float* qd_l = (LAS float*)(F.lds + RING_OFF);
    LAS float* ke_l = qd_l + 512;
    LAS float* dec_l = ke_l + 512;
    LAS float* v_l = dec_l + 128;
    LAS float* aw_l = v_l + 1024;
    LAS float* op_l = aw_l + 32;
    const bf16* GQ = WSP(bf16, WS_GQ); const bf16* GK = WSP(bf16, WS_GK); const bf16* GV = WSP(bf16, WS_GV); const float* GD = WSP(float, WS_GD);
    float* GO = WSP(float, WS_GO);
    for (int uidx = F.bid; uidx < NBS * 4; uidx += F.G) {
        const int b = uidx >> 2, h = uidx & 3; const size_t rs0 = (size_t)MP + 4 * b;
        __syncthreads();
        if (F.tid < 128) {
            const int k = F.tid, col = h * 128 + k;
            float bt[4], qv[4], kv[4]; float bc = 0.f;
#pragma unroll
            for (int t = 0; t < 4; ++t) {
                float z = F.inp(21)[col];
#pragma unroll
                for (int j = 0; j < 16; ++j) z += GD[(rs0 + t) * 16 + j] * F.inp(20)[j * 512 + col];
                bc += log_sigmoid(z) * 0.0625f; bt[t] = bc;
                qv[t] = bf2f(GQ[(rs0 + t) * 512 + col]); kv[t] = bf2f(GK[(rs0 + t) * 512 + col]);
            }
#pragma unroll
            for (int t = 0; t < 4; ++t) { qd_l[t * 128 + k] = qv[t] * __expf(bt[t]); ke_l[t * 128 + k] = kv[t] * __expf(bt[3] - bt[t]); }
            dec_l[k] = __expf(bt[3]);
            int p = 0;
#pragma unroll
            for (int t = 0; t < 4; ++t)
#pragma unroll
                for (int s = 0; s <= t; ++s) { const float term = wave_sum(qv[t] * kv[s] * __expf(bt[t] - bt[s])); if (F.lane == 0) aw_l[F.wave * 16 + p] = term; ++p; }
        } else {
            for (int i = F.tid - 128; i < 1024; i += 384) { const int t = i >> 8, c = i & 255; v_l[i] = bf2f(GV[(rs0 + t) * 1024 + h * 256 + c]); }
        }
        __syncthreads();
        const int v4 = (F.tid & 63) * 4, kg = F.tid >> 6;
        const float* S0 = F.inp(6) + ((size_t)(b * 4 + h) * 128) * 256 + v4;
        float* Sf = F_OUT + O_GLAS + ((size_t)(b * 4 + h) * 128) * 256 + v4;
        const f32x4 v0 = *(const LAS f32x4*)(v_l + v4), v1 = *(const LAS f32x4*)(v_l + 256 + v4), v2 = *(const LAS f32x4*)(v_l + 512 + v4), v3 = *(const LAS f32x4*)(v_l + 768 + v4);
        f32x4 o0 = {0.f, 0.f, 0.f, 0.f}, o1 = o0, o2 = o0, o3 = o0;
        f32x4 sv[16];
#pragma unroll
        for (int kk = 0; kk < 16; ++kk) sv[kk] = __builtin_nontemporal_load((const f32x4*)(S0 + (size_t)(16 * kg + kk) * 256));
#pragma unroll
        for (int kk = 0; kk < 16; ++kk) {
            const int k = 16 * kg + kk; const f32x4 s0 = sv[kk];
            o0 += s0 * qd_l[k]; o1 += s0 * qd_l[128 + k]; o2 += s0 * qd_l[256 + k]; o3 += s0 * qd_l[384 + k];
            const f32x4 sf = s0 * dec_l[k] + ((v0 * ke_l[k] + v1 * ke_l[128 + k]) + (v2 * ke_l[256 + k] + v3 * ke_l[384 + k]));
            __builtin_nontemporal_store(sf, (f32x4*)(Sf + (size_t)k * 256));
        }
        *(LAS f32x4*)(op_l + (kg * 4 + 0) * 256 + v4) = o0; *(LAS f32x4*)(op_l + (kg * 4 + 1) * 256 + v4) = o1;
        *(LAS f32x4*)(op_l + (kg * 4 + 2) * 256 + v4) = o2; *(LAS f32x4*)(op_l + (kg * 4 + 3) * 256 + v4) = o3;
        __syncthreads();
        {
            const int t = F.tid >> 7, c = (F.tid & 127) * 2;
            f32x2 r = {0.f, 0.f};
#pragma unroll
            for (int q = 0; q < 8; ++q) r += *(const LAS f32x2*)(op_l + (q * 4 + t) * 256 + c);
            const int p0 = (t * (t + 1)) >> 1;
            for (int s = 0; s <= t; ++s) { const float a = aw_l[p0 + s] + aw_l[16 + p0 + s]; r += *(const LAS f32x2*)(v_l + s * 256 + c) * a; }
            *(f32x2*)(GO + (rs0 + t) * 1024 + h * 256 + c) = r;
        }
    }
}
__device__ __forceinline__ void gla_post_phase(Frame& F) {
    const float* GO = WSP(float, WS_GO); const bf16* GR = WSP(bf16, WS_GR); bf16* GA = WSP(bf16, WS_GA);
    const int nw = F.G * NWAVES;
    for (int idx0 = F.bid * NWAVES + F.wave; idx0 < M * 4; idx0 += 8 * nw) {
        f32x4 o[8]; v2u rw[8];
#pragma unroll
        for (int u = 0; u < 8; ++u) { const int idx = idx0 + u * nw < M * 4 ? idx0 + u * nw : idx0; const size_t off = (size_t)(idx >> 2) * 1024 + (idx & 3) * 256 + 4 * F.lane;
            o[u] = *(const f32x4*)(GO + off); rw[u] = *(const v2u*)(GR + off); }
#pragma unroll
        for (int u = 0; u < 8; ++u) { const int idx = idx0 + u * nw; if (idx < M * 4) { const size_t off = (size_t)(idx >> 2) * 1024 + (idx & 3) * 256 + 4 * F.lane;
            const float ss = wave_sum((o[u][0] * o[u][0] + o[u][1] * o[u][1]) + (o[u][2] * o[u][2] + o[u][3] * o[u][3]));
            const float rinv = __builtin_amdgcn_rsqf(ss * (1.0f / 256.0f) + EPS);
            const f32x4 gn = *(const f32x4*)(F.inp(22) + (idx & 3) * 256 + 4 * F.lane);
            const float r[4] = {bflo(rw[u].x), bfhi(rw[u].x), bflo(rw[u].y), bfhi(rw[u].y)};
            float y[4];
#pragma unroll
            for (int j = 0; j < 4; ++j) y[j] = (o[u][j] * rinv * gn[j]) * (r[j] / (1.0f + __expf(-r[j])));
            v2u w; w.x = pk2(y[0], y[1]); w.y = pk2(y[2], y[3]); *(v2u*)(GA + off) = w; } }
    }
}
__device__ __forceinline__ void final_norm_phase(Frame& F, int first_row) {
    const int nw = F.G * NWAVES;
    for (int row0 = first_row + F.bid * NWAVES + F.wave; row0 < M; row0 += 2 * nw) {
        f32x4 v[2][4];
#pragma unroll
        for (int u = 0; u < 2; ++u) { const int row = row0 + u * nw < M ? row0 + u * nw : row0; const float* xr = F_OUT + O_Y + (size_t)row * D;
#pragma unroll
            for (int j = 0; j < 4; ++j) v[u][j] = *(const f32x4*)(xr + 4 * F.lane + 256 * j); }
#pragma unroll
        for (int u = 0; u < 2; ++u) { const int row = row0 + u * nw; if (row < M) { float* xr = F_OUT + O_Y + (size_t)row * D; float s = 0.f;
#pragma unroll
            for (int j = 0; j < 4; ++j) s += (v[u][j][0] * v[u][j][0] + v[u][j][1] * v[u][j][1]) + (v[u][j][2] * v[u][j][2] + v[u][j][3] * v[u][j][3]);
            const float rinv = __builtin_amdgcn_rsqf(wave_sum(s) * (1.0f / D) + EPS);
#pragma unroll
            for (int j = 0; j < 4; ++j) { const f32x4 gn = *(const f32x4*)(F.inp(13) + 4 * F.lane + 256 * j); *(f32x4*)(xr + 4 * F.lane + 256 * j) = v[u][j] * rinv * gn; } } }
    }
}
#ifndef REP_MASK
#define REP_MASK 0
#endif
#define NREP(k) (1 + ((REP_MASK >> (k)) & 1))
#ifndef PH_MASK
#define PH_MASK 0xFFFF
#endif
#define EN_P0 ((PH_MASK >> 0) & 1)
#define EN_MOD ((PH_MASK >> 1) & 1)
#define EN_CB ((PH_MASK >> 2) & 1)
#define EN_POOL ((PH_MASK >> 3) & 1)
#define EN_QKV ((PH_MASK >> 4) & 1)
#define EN_ATTN ((PH_MASK >> 5) & 1)
#define EN_MERGE ((PH_MASK >> 6) & 1)
#define EN_GLAIN ((PH_MASK >> 7) & 1)
#define EN_PREP ((PH_MASK >> 8) & 1)
#define EN_SCAN ((PH_MASK >> 9) & 1)
#define EN_POST ((PH_MASK >> 10) & 1)
#define EN_MIX ((PH_MASK >> 11) & 1)
#define EN_FFNIN ((PH_MASK >> 12) & 1)
#define EN_FIX ((PH_MASK >> 13) & 1)
#define EN_FFND ((PH_MASK >> 14) & 1)
#define EN_FINAL ((PH_MASK >> 15) & 1)

struct CbOrder {
    int G, c;
    __device__ bool next(int i, pg8::Unit& u) const { const int L = i * G + c; if (L >= 110) return false; u.pn = L; u.pm = L < 88 ? L / 22 : (L < 97 ? 4 : 5); return true; }
    __device__ __forceinline__ void a_ready(const pg8::Unit&) const {}
    __device__ __forceinline__ void done(const pg8::Unit&) const {}
};
constexpr int NPH = 27;
struct Args { const float* in[28]; float* out; unsigned char* ws; int ph_lo, ph_hi; };
__global__ void __launch_bounds__(NWAVES * 64, 2) hybrid_fwd(Args args) {
    extern __shared__ __attribute__((aligned(16))) unsigned char lds[];
    Frame F;
    F.lds = (LAS unsigned char*)lds;
    F.tid = threadIdx.x; F.lane = F.tid & 63; F.wave = __builtin_amdgcn_readfirstlane(F.tid >> 6);
    F.G = gridDim.x; F.bid = blockIdx.x;
    F.ka = (const __attribute__((address_space(4))) unsigned char*)__builtin_amdgcn_kernarg_segment_ptr();
    F.out_g = (GAS float*)args.out; F.ws_g = (GAS unsigned char*)args.ws;
    for (int u = F.tid; u < (LDS_BYTES - LDSCTL_OFF) / 4; u += NWAVES * 64) ((LAS unsigned*)(F.lds + LDSCTL_OFF))[u] = 0u;
    __syncthreads();
    const int lo = args.ph_lo, hi = args.ph_hi;
    XcdBarrier bar; bar.bar = (unsigned*)(F_WS + WS_CTL) + CW_BAR; bar.x = 0; bar.st = nullptr;
    if (hi - lo > 1) bar = xcd_barrier_post((unsigned*)(F_WS + WS_CTL) + CW_BAR, (volatile LAS unsigned*)(F.lds + MISC_OFF) + 8, F.tid);
    int ph = 0;
#define RELAUNDER() do { asm volatile("" : "+s"(F.wave)); F.lane = fresh_lane(); F.tid = F.wave * 64 + F.lane; asm volatile("" : "+s"(F.ws_g), "+s"(F.out_g), "+s"(F.ka), "+s"(F.G), "+s"(F.bid)); } while (0)
#define IN() (lo <= ph && ph < hi)
#define REPBAR(r) (((r) > 0 && hi - lo > 1) ? (xcd_barrier(bar, F.tid), true) : true)
#define SEAM() do { if (lo <= ph && ph + 1 < hi) xcd_barrier(bar, F.tid); ++ph; RELAUNDER(); } while (0)
#define X (F_OUT + O_Y)
#define xs_in (F.inp(1) - (size_t)MP * D)
#define MOD WSP(float, WS_MOD)
#define RS0 WSP(float, WS_RSS)
#define RS1 (WSP(float, WS_RSS) + 262144)
#define ZERO_ROWSUMS(p) do { for (int i_ = F.bid * 512 + F.tid; i_ < M; i_ += F.G * 512) (p)[i_] = 0.f; } while (0)
#define CB WSP(float, WS_CB)
#define AN WSP(bf16, WS_AN)

    for (int rep_ = 0; rep_ < NREP(0); ++rep_) if (EN_P0 && IN() && REPBAR(rep_)) { p0_prologue(F); ZERO_ROWSUMS(RS0); ZERO_ROWSUMS(RS1); __syncthreads(); mod_direct_phase(F); }
    SEAM();
    for (int l = 0; l < 4; ++l) {
        const int kind = l % 3, jl = l / 3;
        if (kind == 0) {
            for (int rep_ = 0; rep_ < NREP(3); ++rep_) if (EN_POOL && IN() && REPBAR(rep_)) {
                if (EN_CB && l == 0) {
                    pg8::Gemm g{WSP(bf16, WS_SH), WSP(bf16, WS_WNF), 1024, 1024, 1024, 0}; CbOrder S{F.G, F.bid};
                    pg8::EpiCb E{CB};
                    pg8::gemm_phase<pg8::EpiCb, CbOrder, true, true>(F.lds + RING_OFF, g, S, E, F.wave);
                    __syncthreads();
                }
                pool_diff_phase(F, l, jl, (l == 0) ? F.inp(0) : X, (l == 0) ? xs_in : X, (l == 0) ? nullptr : RS1, EN_CB && l == 0 && F.G == 256);
            }
            SEAM();
        } else if (kind == 1) {
            for (int rep_ = 0; rep_ < NREP(4); ++rep_) if (EN_QKV && IN() && REPBAR(rep_)) {
                pg8::Gemm g{AN, WSP(bf16, WS_WNF) + (size_t)22528 * 1024, 1024, 1024, 1024, 0}; pg8::StaticOrder S; S.init(M, 2304, F.G, F.bid);
                pg8::EpiQkv E{RS1, CB + (size_t)4 * 256 * 5632, WSP(bf16, WS_QB), F_OUT, pg8::EpiRide{F.inp(5), F_OUT + O_W3S, 1332, (F.G == 256 && !rep_) ? 592 : 0}};
                pg8::gemm_phase<pg8::EpiQkv, pg8::StaticOrder, true, true>(F.lds + RING_OFF, g, S, E, F.wave);
                { const int nwg_ = 66 * 9, maxu_ = (nwg_ + F.G - 1) / F.G, myu_ = (nwg_ - F.bid + F.G - 1) / F.G; if (!rep_ && myu_ < maxu_) copy_pull(F, 2); }
            }
            SEAM();
            for (int rep_ = 0; rep_ < NREP(5); ++rep_) if (EN_ATTN && IN() && REPBAR(rep_)) attn_phase(F);
            SEAM();
            for (int rep_ = 0; rep_ < NREP(6); ++rep_) if (EN_MERGE && IN() && REPBAR(rep_)) attn_merge_phase(F);
            SEAM();
        } else {
            for (int rep_ = 0; rep_ < NREP(7); ++rep_) if (EN_GLAIN && IN() && REPBAR(rep_)) {
                pg8::Gemm g{AN, WSP(bf16, WS_WNF) + (size_t)24832 * 1024, 1024, 1024, 1024, 0}; pg8::StaticOrder S; S.init(M, 3328, F.G, F.bid);
                pg8::EpiGlaIn E{RS1, CB + (size_t)4 * 256 * 5632 + (size_t)256 * 2304, WSP(bf16, WS_GQ), WSP(float, WS_GD), pg8::EpiRide{F.inp(5), F_OUT + O_W3S, 1406, (F.G == 256 && !rep_) ? 856 : 0}};
                pg8::gemm_phase<pg8::EpiGlaIn, pg8::StaticOrder, true, true>(F.lds + RING_OFF, g, S, E, F.wave);
                { const int nwg_ = 66 * 13, maxu_ = (nwg_ + F.G - 1) / F.G, myu_ = (nwg_ - F.bid + F.G - 1) / F.G; if (!rep_ && myu_ < maxu_) copy_pull(F, 2); }
            }
            SEAM();
            for (int rep_ = 0; rep_ < NREP(8); ++rep_) if (EN_PREP && IN() && REPBAR(rep_)) { gla_prep_phase(F); gla_sample_phase(F); }
            SEAM();
            for (int rep_ = 0; rep_ < NREP(9); ++rep_) if (EN_SCAN && IN() && REPBAR(rep_)) gla_scan_phase(F);
            SEAM();
            for (int rep_ = 0; rep_ < NREP(10); ++rep_) if (EN_POST && IN() && REPBAR(rep_)) gla_post_phase(F);
            SEAM();
        }
        for (int rep_ = 0; rep_ < NREP(11); ++rep_) if (EN_MIX && IN() && REPBAR(rep_)) {
            pg8::StaticOrder S; S.init(MP, 1024, F.G, F.bid);
            const pg8::Gemm gm = kind == 0 ? pg8::Gemm{WSP(bf16, WS_DP), WSP(bf16, WS_WP) + (size_t)jl * 1024 * 256, 1024, 256, 256, 256}
                               : (kind == 1 ? pg8::Gemm{WSP(bf16, WS_AO), WSP(bf16, WS_WAO), 768, 768, 768, 0} : pg8::Gemm{WSP(bf16, WS_GA), WSP(bf16, WS_WGO), 1024, 1024, 1024, 0});
            pg8::EpiRes E{(l == 0) ? F.inp(0) : X, (l == 0) ? xs_in : X, rep_ ? WSP(float, WS_DUMMY) : X, MOD + l * 6144 + 2 * 1024, kind == 0 ? F.inp(16) + (size_t)jl * D : nullptr,
                          F.inp(12) + (size_t)(l * 2 + 1) * D, MOD + l * 6144 + 4 * 1024, rep_ ? WSP(bf16, WS_DUMMY2) : AN, rep_ ? WSP(float, WS_DUMMY3) : RS0, nullptr, nullptr};
            if (!rep_) ZERO_ROWSUMS(RS1);
            pg8::gemm_phase<pg8::EpiRes, pg8::StaticOrder, true, true>(F.lds + RING_OFF, gm, S, E, F.wave);
            rider_res(F, gm, E);
        }
        SEAM();
        for (int rep_ = 0; rep_ < NREP(12); ++rep_) if (EN_FFNIN && IN() && REPBAR(rep_)) {
            pg8::Gemm g{AN, WSP(bf16, WS_WNF) + (size_t)l * 5632 * 1024, 1024, 1024, 1024, 0}; pg8::StaticOrder S; S.init(M, 5632, F.G, F.bid);
            pg8::EpiFfnIn E{RS0, CB + (size_t)l * 256 * 5632, F.inp(25) + (size_t)l * 3 * DFF, F.inp(26) + (size_t)l * DFF, F.inp(7) + (size_t)l * NBS * 2 * DFF,
                            WSP(bf16, WS_ACT), WSP(float, WS_HG), WSP(float, WS_HU), WSP(float, WS_TG), F_OUT + O_CONVP + (size_t)l * NBP * 2 * DFF, F_OUT + O_CONVS + (size_t)l * NBS * 2 * DFF,
                            pg8::EpiRide{F.inp(5), F_OUT + O_W3S, 1152 + 45 * l, (F.G == 256 && !rep_) ? 1440 : 0}};
            pg8::gemm_phase<pg8::EpiFfnIn, pg8::StaticOrder, true, true>(F.lds + RING_OFF, g, S, E, F.wave);
                { const int nwg_ = 66 * 22, maxu_ = (nwg_ + F.G - 1) / F.G, myu_ = (nwg_ - F.bid + F.G - 1) / F.G; if (!rep_ && myu_ < maxu_) copy_pull(F, 2); }
        }
        SEAM();
        for (int rep_ = 0; rep_ < NREP(13); ++rep_) if (EN_FIX && IN() && REPBAR(rep_)) ffn_fixup_phase(F, l);
        SEAM();
        for (int rep_ = 0; rep_ < NREP(14); ++rep_) if (EN_FFND && IN() && REPBAR(rep_)) {
            pg8::Gemm g{WSP(bf16, WS_ACT), WSP(bf16, WS_WD) + (size_t)l * 1024 * DFF, DFF, DFF, DFF, 0}; pg8::StaticOrder S; S.init(MP, 1024, F.G, F.bid);
            pg8::EpiRes E{X, X, rep_ ? WSP(float, WS_DUMMY) : X, MOD + l * 6144 + 5 * 1024, nullptr,
                          (l < 3 && (l + 1) % 3 != 0) ? F.inp(12) + (size_t)((l + 1) * 2) * D : nullptr, MOD + (l + 1) * 6144 + 1 * 1024, rep_ ? WSP(bf16, WS_DUMMY2) : AN, rep_ ? WSP(float, WS_DUMMY3) : RS1,
                          (l == 3 && !rep_ && F.G == 256) ? F.inp(13) : nullptr, (unsigned*)(F_WS + WS_CTL) + CW_FINCNT};
            if (!rep_) ZERO_ROWSUMS(RS0);
            pg8::gemm_phase<pg8::EpiRes, pg8::StaticOrder, true, true>(F.lds + RING_OFF, g, S, E, F.wave);
            rider_res(F, g, E);
        }
        SEAM();
    }
    for (int rep_ = 0; rep_ < NREP(15); ++rep_) if (EN_FINAL && IN() && REPBAR(rep_)) { final_norm_phase(F, F.G == 256 ? MP : 0); copy_pull(F, 0); }
#undef X
#undef xs_in
#undef MOD
#undef RS0
#undef RS1
#undef CB
#undef AN
#undef IN
#undef SEAM
}

extern "C" void kernel_launch(void* const* d_in, const int* in_sizes, int n_in, void* d_out, int out_size, void* d_ws, size_t ws_size, hipStream_t stream) {
    static int grid = 0;
    if (grid == 0) {
        if (n_in != 28 || (size_t)out_size != O_END || ws_size < WS_END) { fprintf(stderr, "kernel_launch: unexpected shapes: n_in %d out %d (want %zu) ws %zu (want %zu)\n", n_in, out_size, (size_t)O_END, ws_size, (size_t)WS_END); grid = -1; return; }
        int dev = 0, cus = 0, per_cu = 0;
        if (hipGetDevice(&dev) != hipSuccess || hipDeviceGetAttribute(&cus, hipDeviceAttributeMultiprocessorCount, dev) != hipSuccess) { fprintf(stderr, "kernel_launch: device query failed\n"); grid = -1; return; }
        if (hipFuncSetAttribute((const void*)hybrid_fwd, hipFuncAttributeMaxDynamicSharedMemorySize, LDS_BYTES) != hipSuccess) { fprintf(stderr, "kernel_launch: hipFuncSetAttribute failed\n"); grid = -1; return; }
        if (hipOccupancyMaxActiveBlocksPerMultiprocessor(&per_cu, (const void*)hybrid_fwd, NWAVES * 64, LDS_BYTES) != hipSuccess || per_cu < 1)
            fprintf(stderr, "kernel_launch: note: occupancy query reports %d workgroups per CU\n", per_cu);
        (void)hipGetLastError();
        grid = cus;
    }
    if (grid < 0) return;
    if (hipMemsetAsync((char*)d_ws + WS_CTL, 0, CTL_ZERO_BYTES, stream) != hipSuccess) { fprintf(stderr, "kernel_launch: memset failed\n"); return; }
    Args a{};
    for (int i = 0; i < 28; ++i) a.in[i] = (const float*)d_in[i];
    a.out = (float*)d_out; a.ws = (unsigned char*)d_ws;
#if MK_LAUNCH_PER_PHASE
    for (int p = 0; p < NPH; ++p) { a.ph_lo = p; a.ph_hi = p + 1; hipLaunchKernelGGL(hybrid_fwd, dim3(grid), dim3(NWAVES * 64), LDS_BYTES, stream, a); }
#else
    a.ph_lo = 0; a.ph_hi = NPH; hipLaunchKernelGGL(hybrid_fwd, dim3(grid), dim3(NWAVES * 64), LDS_BYTES, stream, a);
#endif
    const hipError_t le = hipPeekAtLastError();
    if (le != hipSuccess) fprintf(stderr, "kernel_launch: launch failed: %s\n", hipGetErrorName(le));
}
```

```cpp
#include <hip/hip_runtime.h>
#include <cstdio>
#include <cstdint>

#ifndef MK_LAUNCH_PER_PHASE
#define MK_LAUNCH_PER_PHASE 0
#endif

constexpr int D = 1024, MP = 16384, MS = 512, M = MP + MS, TP = 2048, NBP = 8, NBS = 128, DFF = 2816, NBI = 136;
constexpr int MODLD = 24576;
constexpr int NWNF = 28160;
constexpr float EPS = 1e-6f;

#define GAS __attribute__((address_space(1)))
#define LAS __attribute__((address_space(3)))
typedef unsigned short bf16;
typedef unsigned v4u __attribute__((ext_vector_type(4)));
typedef unsigned v2u __attribute__((ext_vector_type(2)));
typedef float f32x4 __attribute__((ext_vector_type(4)));
typedef float f32x2 __attribute__((ext_vector_type(2)));
typedef short bf16x8 __attribute__((ext_vector_type(8)));
typedef __bf16 hbf2 __attribute__((ext_vector_type(2)));
#define LDS_WAIT() asm volatile("s_waitcnt lgkmcnt(0)" ::: "memory")
#define VM_WAIT() asm volatile("s_waitcnt vmcnt(0)" ::: "memory")
__device__ __forceinline__ unsigned pk2(float lo, float hi) { f32x2 v = {lo, hi}; return __builtin_bit_cast(unsigned, __builtin_convertvector(v, hbf2)); }
__device__ __forceinline__ float bf2f(unsigned short b) { return __builtin_bit_cast(float, ((unsigned)b) << 16); }
__device__ __forceinline__ float bflo(unsigned w) { return __builtin_bit_cast(float, w << 16); }
__device__ __forceinline__ float bfhi(unsigned w) { return __builtin_bit_cast(float, w & 0xffff0000u); }
__device__ __forceinline__ float wave_sum(float v) {
#pragma unroll
    for (int o = 1; o < 64; o <<= 1) v += __shfl_xor(v, o);
    return v;
}
__device__ __forceinline__ int batch_of_row(int r) { return r < MP ? (r >> 11) : NBP + ((r - MP) >> 2); }

__device__ __forceinline__ int fresh_lane() { int l = (int)__builtin_amdgcn_mbcnt_hi(~0u, __builtin_amdgcn_mbcnt_lo(~0u, 0u)); asm volatile("" : "+v"(l)); return l; }
#define MFMA16(a, b, c) __builtin_amdgcn_mfma_f32_16x16x32_bf16((a), (b), (c), 0, 0, 0)
#define LDS_BARRIER() do { asm volatile("s_waitcnt lgkmcnt(0)" ::: "memory"); __builtin_amdgcn_s_barrier(); asm volatile("" ::: "memory"); } while (0)

constexpr size_t MiB = 1u << 20;
constexpr size_t WS_CTL = 0, CTL_ZERO_BYTES = 1 * MiB;
constexpr size_t WS_WNF  = 1 * MiB;
constexpr size_t WS_WD   = WS_WNF + 56 * MiB;
constexpr size_t WS_WAO  = WS_WD + 23 * MiB;
constexpr size_t WS_WGO  = WS_WAO + 2 * MiB;
constexpr size_t WS_WP   = WS_WGO + 2 * MiB;
constexpr size_t WS_WADA = WS_WP + 1 * MiB;
constexpr size_t WS_SC   = WS_WADA + 48 * MiB;
constexpr size_t WS_SH   = WS_SC + 1 * MiB;
constexpr size_t WS_MOD  = WS_SH + 3 * MiB;
constexpr size_t WS_CB   = WS_MOD + 13 * MiB;
constexpr size_t WS_AN   = WS_CB + 28 * MiB;
constexpr size_t WS_DP   = WS_AN + 33 * MiB;
constexpr size_t WS_ACT  = WS_DP + 33 * MiB;
constexpr size_t WS_HG   = WS_ACT + 91 * MiB;
constexpr size_t WS_HU   = WS_HG + 6 * MiB;
constexpr size_t WS_TG   = WS_HU + 6 * MiB;
constexpr size_t WS_RSS  = WS_TG + 6 * MiB;
constexpr size_t WS_QB   = WS_RSS + 2 * MiB;
constexpr size_t WS_KB   = WS_QB + 25 * MiB;
constexpr size_t WS_VB   = WS_KB + 25 * MiB;
constexpr size_t WS_AO   = WS_VB + 25 * MiB;
constexpr size_t WS_LSE  = WS_AO + 25 * MiB;
constexpr size_t WS_GQ   = WS_LSE + 1 * MiB;
constexpr size_t WS_GK   = WS_GQ + 17 * MiB;
constexpr size_t WS_QD   = WS_GK + 17 * MiB;
constexpr size_t WS_KET  = WS_QD + 17 * MiB;
constexpr size_t WS_ATT  = WS_KET + 16 * MiB;
constexpr size_t WS_DEC  = WS_ATT + 8 * MiB;
constexpr size_t WS_GV   = WS_DEC + 1 * MiB;
constexpr size_t WS_GR   = WS_GV + 33 * MiB;
constexpr size_t WS_GD   = WS_GR + 33 * MiB;
constexpr size_t WS_GO   = WS_GD + 2 * MiB;
constexpr size_t WS_GA   = WS_GO + 66 * MiB;
constexpr size_t WS_DUMMY = WS_GA + 33 * MiB;
constexpr size_t WS_DUMMY2 = WS_DUMMY + 66 * MiB;
constexpr size_t WS_DUMMY3 = WS_DUMMY2 + 33 * MiB;
constexpr size_t WS_END  = WS_DUMMY3 + 2 * MiB;
constexpr int CW_BAR = 4096;
constexpr int CW_FINCNT = 16384;

constexpr size_t O_Y     = 0;
constexpr size_t O_POOLP = O_Y + (size_t)M * D;
constexpr size_t O_POOLS = O_POOLP + (size_t)2 * 8 * 15 * D;
constexpr size_t O_W1P   = O_POOLS + (size_t)2 * 128 * 15 * D;
constexpr size_t O_W1S   = O_W1P + (size_t)8 * 128 * 512;
constexpr size_t O_W2P   = O_W1S + (size_t)128 * 128 * 512;
constexpr size_t O_W2S   = O_W2P + (size_t)8 * 512 * 512;
constexpr size_t O_W3P   = O_W2S + (size_t)128 * 512 * 512;
constexpr size_t O_W3S   = O_W3P + (size_t)8 * 2048 * 512;
constexpr size_t O_GLAP  = O_W3S + (size_t)128 * 2048 * 512;
constexpr size_t O_GLAS  = O_GLAP + (size_t)8 * 4 * 128 * 256;
constexpr size_t O_CONVP = O_GLAS + (size_t)128 * 4 * 128 * 256;
constexpr size_t O_CONVS = O_CONVP + (size_t)4 * 8 * 2 * DFF;
constexpr size_t O_END   = O_CONVS + (size_t)4 * 128 * 2 * DFF;

namespace pg8 {
#define PG8_LAS __attribute__((address_space(3)))
typedef unsigned short bf16_t;
typedef short bf16x8 __attribute__((ext_vector_type(8)));
typedef float f32x4 __attribute__((ext_vector_type(4)));
typedef unsigned u32x4 __attribute__((ext_vector_type(4)));
constexpr int BM = 256, BK = 64, HALF = 128, HTB = HALF * BK * 2  , STAGE_BYTES = 8 * HTB, NXCD = 8, WGM = 8;

__host__ __device__ __forceinline__ int lds_byte(int r, int c) { const int st = (r >> 4) * 2 + (c >> 5), rr = r & 15, cc = c & 31, ob = rr * 64 + cc * 2; return st * 1024 + (ob ^ (((ob >> 9) & 1) << 5)); }
__host__ __device__ __forceinline__ void stage_rc(int b, int& R, int& C) { const int st = b / 1024, sb = b % 1024, swz = sb ^ (((sb >> 9) & 1) << 5); R = (st >> 1) * 16 + swz / 64; C = (st & 1) * 32 + (swz % 64) / 2; }
__host__ __device__ __forceinline__ int perm32(int rho) { const int n = rho >> 4, i = rho & 15; return 8 * (i >> 2) + 4 * n + (i & 3); }

struct Unit { int pm, pn; };
struct Gemm { const bf16_t* A; const bf16_t* Bt; int lda, ldb, K, a_pn; };

struct StaticOrder {
    int nM, nN, nwg, G, c;
    __host__ __device__ __forceinline__ void init(int M_, int N_, int G_, int c_) { nM = M_ / BM; nN = N_ / BM; nwg = nM * nN; G = G_; c = c_; }
    __host__ __device__ __forceinline__ bool next(int i, Unit& u) const {
        const long L = (long)i * G + c; if (L >= nwg) return false;
        int wgid = (int)L; { const int q = nwg / NXCD, r = nwg % NXCD, xcd = wgid % NXCD, off = wgid / NXCD; wgid = (xcd < r ? xcd * (q + 1) : r * (q + 1) + (xcd - r) * q) + off; }
        const int nig = WGM * nN, gid = wgid / nig, fm = gid * WGM, gsz = (nM - fm) < WGM ? (nM - fm) : WGM;
        u.pm = fm + ((wgid % nig) % gsz); u.pn = (wgid % nig) / gsz; return true;
    }
    __device__ __forceinline__ void a_ready(const Unit&) const {}
    __device__ __forceinline__ void done(const Unit&) const {}
};

template <class Epi, class Sched, bool ALIGN_EPI = false, bool SP2 = false>
__device__ __forceinline__ void gemm_phase(PG8_LAS unsigned char* lds, const Gemm g, const Sched& S, const Epi& E, int wave_id  ) {
    const int lane = fresh_lane(), wid = wave_id, tid = wid * 64 + lane, wr = wid >> 2, wc = wid & 3, fr = lane & 15, fq = lane >> 4;
    const int K = g.K, nt = K / BK;
    unsigned voffA[2], voffB[2];
#pragma unroll
    for (int i = 0; i < 2; ++i) { int R, C; stage_rc(tid * 16 + i * 8192, R, C); const int Rb = Epi::PERM ? ((R & ~31) + perm32(R & 31)) : R;
        voffA[i] = (unsigned)(R * g.lda + C) * 2u; voffB[i] = (unsigned)(Rb * g.ldb + C) * 2u; }
    const size_t kstep = (size_t)(BK * 2);
    const size_t hstepA = (size_t)HALF * g.lda * 2, hstepB = (size_t)HALF * g.ldb * 2;
    const size_t tstepA = 2 * hstepA, tstepB = 2 * hstepB, pnA = (size_t)g.a_pn * 2;
    const unsigned ldsw = (unsigned)wid * 1024u;
    const int aoff = lds_byte(wr * 64 + fr, fq * 8), boff = lds_byte(wc * 32 + fr, fq * 8);
#define PG8_SA(b, h) (((b) * 2 + (h)) * HTB)
#define PG8_SB(b, h) ((4 + (b) * 2 + (h)) * HTB)
#define PG8_STAGE(bufoff, gbase, voff) do { _Pragma("unroll") for (int _i = 0; _i < 2; ++_i) \
        __builtin_amdgcn_global_load_lds((const unsigned*)((const char*)(gbase) + (voff)[_i]), (PG8_LAS unsigned*)(lds + (bufoff) + ldsw + _i * 8192), 16, 0, 0); } while (0)
#define PG8_LDA(dst, b, h) do { _Pragma("unroll") for (int m = 0; m < 4; ++m) _Pragma("unroll") for (int k = 0; k < 2; ++k) dst[m][k] = *(const PG8_LAS bf16x8*)(lds + PG8_SA(b, h) + aoff + m * 2048 + k * 1024); } while (0)
#define PG8_LDB(dst, b, h) do { _Pragma("unroll") for (int n = 0; n < 2; ++n) _Pragma("unroll") for (int k = 0; k < 2; ++k) dst[n][k] = *(const PG8_LAS bf16x8*)(lds + PG8_SB(b, h) + boff + n * 2048 + k * 1024); } while (0)
#define PG8_MMA(ai, bj, At, Bt) do { __builtin_amdgcn_s_setprio(1); _Pragma("unroll") for (int m = 0; m < 4; ++m) _Pragma("unroll") for (int n = 0; n < 2; ++n) _Pragma("unroll") for (int k = 0; k < 2; ++k) \
        acc[ai][bj][m][n] = __builtin_amdgcn_mfma_f32_16x16x32_bf16(Bt[n][k], At[m][k], acc[ai][bj][m][n], 0, 0, 0); __builtin_amdgcn_s_setprio(0); } while (0)
#define PG8_WAIT_V(n) asm volatile("s_waitcnt vmcnt(" #n ")" ::: "memory")
#define PG8_WAIT_L(n) asm volatile("s_waitcnt lgkmcnt(" #n ")" ::: "memory")
#define PG8_BAR __builtin_amdgcn_s_barrier()
#define PG8_SCHED __builtin_amdgcn_sched_barrier(0)
    Unit cur, nxt; int ui = 0;
    if (!S.next(0, cur)) return;
    f32x4 acc[2][2][4][2];
#pragma unroll
    for (int a = 0; a < 2; ++a)
#pragma unroll
        for (int b = 0; b < 2; ++b)
#pragma unroll
            for (int m = 0; m < 4; ++m)
#pragma unroll
                for (int n = 0; n < 2; ++n) acc[a][b][m][n] = (f32x4){0.f, 0.f, 0.f, 0.f};
    bf16x8 At[4][2], B0[2][2], B1[2][2];
    const char* cA = (const char*)g.A + (size_t)cur.pm * tstepA + (size_t)cur.pn * pnA; const char* cB = (const char*)g.Bt + (size_t)cur.pn * tstepB;
    S.a_ready(cur);
    if constexpr (SP2) {
        PG8_STAGE(PG8_SB(0, 0), cB, voffB); PG8_STAGE(PG8_SB(0, 1), cB + hstepB, voffB); PG8_STAGE(PG8_SA(0, 0), cA, voffA); PG8_STAGE(PG8_SA(0, 1), cA + hstepA, voffA);
        if (wr == 1) PG8_BAR;
        PG8_WAIT_V(2); PG8_BAR;
        PG8_STAGE(PG8_SB(1, 0), cB + kstep, voffB); PG8_STAGE(PG8_SA(1, 0), cA + kstep, voffA); PG8_STAGE(PG8_SB(1, 1), cB + hstepB + kstep, voffB);
        PG8_WAIT_V(6); PG8_BAR;
    } else {
        PG8_STAGE(PG8_SB(0, 0), cB, voffB); PG8_STAGE(PG8_SA(0, 0), cA, voffA); PG8_STAGE(PG8_SB(0, 1), cB + hstepB, voffB); PG8_STAGE(PG8_SA(0, 1), cA + hstepA, voffA);
        if (wr == 1) PG8_BAR;
        PG8_WAIT_V(4); PG8_BAR;
        PG8_STAGE(PG8_SB(1, 0), cB + kstep, voffB); PG8_STAGE(PG8_SA(1, 0), cA + kstep, voffA); PG8_STAGE(PG8_SB(1, 1), cB + hstepB + kstep, voffB);
        PG8_WAIT_V(6); PG8_BAR;
    }
    for (;;) {
        const bool has_next = S.next(ui + 1, nxt);
        const char* nA = has_next ? (const char*)g.A + (size_t)nxt.pm * tstepA + (size_t)nxt.pn * pnA : cA; const char* nB = has_next ? (const char*)g.Bt + (size_t)nxt.pn * tstepB : cB;
        for (int t = 0; t < nt; t += 2) {
            const bool last = (t == nt - 2);
            const char* a1 = cA + (size_t)(t + 1) * kstep;
            const char* a2 = last ? nA : cA + (size_t)(t + 2) * kstep; const char* b2 = last ? nB : cB + (size_t)(t + 2) * kstep;
            const char* a3 = a2 + kstep; const char* b3 = b2 + kstep;
            if (last && has_next) S.a_ready(nxt);
            if constexpr (SP2) {
            PG8_LDB(B0, 0, 0); PG8_LDB(B1, 0, 1); PG8_SCHED; PG8_LDA(At, 0, 0); PG8_STAGE(PG8_SA(1, 1), a1 + hstepA, voffA);
            PG8_WAIT_V(8); PG8_WAIT_L(0); PG8_BAR; PG8_MMA(0, 0, At, B0); PG8_MMA(0, 1, At, B1); PG8_BAR; PG8_SCHED;
            PG8_LDA(At, 0, 1); PG8_STAGE(PG8_SB(0, 0), b2, voffB); PG8_STAGE(PG8_SB(0, 1), b2 + hstepB, voffB); PG8_STAGE(PG8_SA(0, 0), a2, voffA);
            PG8_WAIT_V(8); PG8_WAIT_L(0); PG8_BAR; PG8_MMA(1, 0, At, B0); PG8_MMA(1, 1, At, B1); PG8_BAR; PG8_SCHED;
            PG8_LDB(B0, 1, 0); PG8_LDB(B1, 1, 1); PG8_SCHED; PG8_LDA(At, 1, 0); PG8_STAGE(PG8_SA(0, 1), a2 + hstepA, voffA);
            PG8_WAIT_V(8); PG8_WAIT_L(0); PG8_BAR; PG8_MMA(0, 0, At, B0); PG8_MMA(0, 1, At, B1); PG8_BAR; PG8_SCHED;
            PG8_LDA(At, 1, 1); PG8_STAGE(PG8_SB(1, 0), b3, voffB); PG8_STAGE(PG8_SB(1, 1), b3 + hstepB, voffB); PG8_STAGE(PG8_SA(1, 0), a3, voffA);
            PG8_WAIT_V(8); PG8_WAIT_L(0); PG8_BAR; PG8_MMA(1, 0, At, B0); PG8_MMA(1, 1, At, B1); PG8_BAR; PG8_SCHED;
            } else {
            PG8_LDB(B0, 0, 0); PG8_SCHED; PG8_LDA(At, 0, 0); PG8_STAGE(PG8_SA(1, 1), a1 + hstepA, voffA);
            PG8_WAIT_L(8); PG8_BAR; PG8_WAIT_L(0); PG8_MMA(0, 0, At, B0); PG8_BAR; PG8_SCHED;
            PG8_LDB(B1, 0, 1); PG8_STAGE(PG8_SB(0, 0), b2, voffB);
            PG8_BAR; PG8_WAIT_L(0); PG8_MMA(0, 1, At, B1); PG8_BAR;
            PG8_LDA(At, 0, 1); PG8_STAGE(PG8_SA(0, 0), a2, voffA);
            PG8_BAR; PG8_WAIT_L(0); PG8_MMA(1, 0, At, B0); PG8_BAR; PG8_SCHED;
            PG8_STAGE(PG8_SB(0, 1), b2 + hstepB, voffB);
            PG8_WAIT_V(6); PG8_BAR; PG8_MMA(1, 1, At, B1); PG8_BAR;
            PG8_LDB(B0, 1, 0); PG8_SCHED; PG8_LDA(At, 1, 0); PG8_STAGE(PG8_SA(0, 1), a2 + hstepA, voffA);
            PG8_WAIT_L(8); PG8_BAR; PG8_WAIT_L(0); PG8_MMA(0, 0, At, B0); PG8_BAR; PG8_SCHED;
            PG8_LDB(B1, 1, 1); PG8_STAGE(PG8_SB(1, 0), b3, voffB);
            PG8_BAR; PG8_WAIT_L(0); PG8_MMA(0, 1, At, B1); PG8_BAR;
            PG8_LDA(At, 1, 1); PG8_STAGE(PG8_SA(1, 0), a3, voffA);
            PG8_BAR; PG8_WAIT_L(0); PG8_MMA(1, 0, At, B0); PG8_BAR; PG8_SCHED;
            PG8_STAGE(PG8_SB(1, 1), b3 + hstepB, voffB);
            PG8_WAIT_V(6); PG8_BAR; PG8_MMA(1, 1, At, B1); PG8_BAR;
            }
        }
        if constexpr (ALIGN_EPI) { if (wr == 0) PG8_BAR; }
        if constexpr (!Epi::AFTER_DRAIN) { E(acc, cur, wr, wc, fr, fq); S.done(cur); }
        if (!has_next) break;
#pragma unroll
        for (int a = 0; a < 2; ++a)
#pragma unroll
            for (int b = 0; b < 2; ++b)
#pragma unroll
                for (int m = 0; m < 4; ++m)
#pragma unroll
                    for (int n = 0; n < 2; ++n) acc[a][b][m][n] = (f32x4){0.f, 0.f, 0.f, 0.f};
        cur = nxt; cA = nA; cB = nB; ++ui;
        if constexpr (ALIGN_EPI) { if (wr == 1) PG8_BAR; }
    }
    PG8_WAIT_V(0);
    if constexpr (!ALIGN_EPI) { if (wr == 0) PG8_BAR; }
    PG8_BAR;
    if constexpr (Epi::AFTER_DRAIN) { E.fused(acc, cur, wr, wc, fr, fq, lds, wid, lane); S.done(cur); }
#undef PG8_SA
#undef PG8_SB
#undef PG8_STAGE
#undef PG8_LDA
#undef PG8_LDB
#undef PG8_MMA
#undef PG8_WAIT_V
#undef PG8_WAIT_L
#undef PG8_BAR
#undef PG8_SCHED
}

typedef float f32x2 __attribute__((ext_vector_type(2)));
typedef __bf16 hb2 __attribute__((ext_vector_type(2)));
typedef unsigned u32x2 __attribute__((ext_vector_type(2)));
__device__ __forceinline__ unsigned cvt_pk_bf16(float lo, float hi) { f32x2 v = {lo, hi}; return __builtin_bit_cast(unsigned, __builtin_convertvector(v, hb2)); }
__device__ __forceinline__ f32x2 gelu_pk(f32x2 v) {
    const f32x2 av = __builtin_elementwise_abs(v), d = av * 0.2316418882f + 1.0f;
    f32x2 t; t.x = __builtin_amdgcn_rcpf(d.x); t.y = __builtin_amdgcn_rcpf(d.y);
    f32x2 q = t * 0.5307027145f + (-0.7265760135f); q = q * t + 0.7107068705f; q = q * t + (-0.142248368f); q = q * t + 0.127414796f; q = q * t;
    const f32x2 s = (v * v) * (-0.72134752044f);
    f32x2 e; e.x = __builtin_amdgcn_exp2f(s.x); e.y = __builtin_amdgcn_exp2f(s.y);
    const f32x2 m = v * (q * e), r = v - m;
    f32x2 o; o.x = v.x < 0.f ? m.x : r.x; o.y = v.y < 0.f ? m.y : r.y; return o;
}
__device__ __forceinline__ float gelu1(float v) { f32x2 r = gelu_pk((f32x2){v, v}); return r.x; }
constexpr int E_MP = 16384, E_DFF = 2816, E_MODLD = 24576;
__device__ __forceinline__ float row_rinv(const float* rss, int row) { return __builtin_amdgcn_rsqf(rss[row] * (1.0f / 1024.0f) + 1e-6f); }
__device__ __forceinline__ float dpp_ror1(float v) { return __builtin_bit_cast(float, __builtin_amdgcn_update_dpp(0, __builtin_bit_cast(int, v), 0x121, 0xf, 0xf, false)); }
__device__ __forceinline__ float dpp_ror2(float v) { return __builtin_bit_cast(float, __builtin_amdgcn_update_dpp(0, __builtin_bit_cast(int, v), 0x122, 0xf, 0xf, false)); }
__device__ __forceinline__ void ld8(const float* p, float (&v)[8]) { const f32x4 a = *(const f32x4*)p, b = *(const f32x4*)(p + 4); v[0] = a[0]; v[1] = a[1]; v[2] = a[2]; v[3] = a[3]; v[4] = b[0]; v[5] = b[1]; v[6] = b[2]; v[7] = b[3]; }
__device__ __forceinline__ void st8(float* p, const float (&v)[8]) { *(f32x4*)p = (f32x4){v[0], v[1], v[2], v[3]}; *(f32x4*)(p + 4) = (f32x4){v[4], v[5], v[6], v[7]}; }
__device__ __forceinline__ void st8bf(bf16_t* p, const float (&v)[8]) { u32x4 w; w.x = cvt_pk_bf16(v[0], v[1]); w.y = cvt_pk_bf16(v[2], v[3]); w.z = cvt_pk_bf16(v[4], v[5]); w.w = cvt_pk_bf16(v[6], v[7]); *(u32x4*)p = w; }

struct EpiRide {
    const float* cache3; float* out3; int sbase, nunits;
    template <int NPT> __device__ __forceinline__ void load(int L, int tid, f32x4 (&v)[NPT], const f32x4*& src, f32x4*& dst, unsigned& e0, unsigned& n) const {
        constexpr int PPS = 32 / NPT;
        const unsigned sl = (unsigned)(sbase + L / PPS), b = sl >> 4, k = sl & 15u;
        src = (const f32x4*)cache3 + (size_t)b * (2048 * 128) + 512 + (size_t)k * 16384; dst = (f32x4*)out3 + (size_t)b * (2048 * 128) + (size_t)k * 16384;
        n = 261632u - k * 16384u < 16384u ? 261632u - k * 16384u : 16384u; e0 = (unsigned)((L % PPS) * NPT * 512 + tid);
#pragma unroll
        for (int u = 0; u < NPT; ++u) { const unsigned e = e0 + (unsigned)(u * 512); v[u] = __builtin_nontemporal_load(src + (e < n ? e : n - 1u)); }
    }
    template <int NPT> __device__ __forceinline__ void store(const f32x4 (&v)[NPT], f32x4* dst, unsigned e0, unsigned n) const {
#pragma unroll
        for (int u = 0; u < NPT; ++u) { const unsigned e = e0 + (unsigned)(u * 512); if (e < n) __builtin_nontemporal_store(v[u], dst + e); }
    }
};
struct EpiMod {
    static constexpr bool PERM = true, AFTER_DRAIN = false;
    float* mod; const float* b_ada; bf16_t* sh;
    __device__ __forceinline__ void operator()(const f32x4 (&acc)[2][2][4][2], const Unit& u, int wr, int wc, int fr, int fq) const {
        const int l = u.pn / 24, rem = u.pn % 24, mi = rem >> 2, cbk = rem & 3;
        const int variant = (mi == 3) ? l : ((mi == 0 && l == 1) ? 4 : ((mi == 0 && l == 2) ? 5 : -1));
#pragma unroll
        for (int bj = 0; bj < 2; ++bj) {
            const int col0 = u.pn * 256 + bj * 128 + wc * 32 + 8 * fq;
            float bv[8]; ld8(b_ada + col0, bv);
#pragma unroll
            for (int ai = 0; ai < 2; ++ai)
#pragma unroll
                for (int m = 0; m < 4; ++m) {
                    const int row = ai * 128 + wr * 64 + m * 16 + fr;
                    float v[8];
#pragma unroll
                    for (int j = 0; j < 4; ++j) { v[j] = acc[ai][bj][m][0][j] + bv[j]; v[4 + j] = acc[ai][bj][m][1][j] + bv[4 + j]; }
                    if (row < 136) st8(mod + (size_t)row * E_MODLD + col0, v);
                    if (variant >= 0) st8bf(sh + ((size_t)(variant * 256 + row)) * 1024 + cbk * 256 + bj * 128 + wc * 32 + 8 * fq, v);
                }
        }
    }
};
struct EpiCb {
    static constexpr bool PERM = true, AFTER_DRAIN = false;
    float* cb;
    __device__ __forceinline__ void operator()(const f32x4 (&acc)[2][2][4][2], const Unit& u, int wr, int wc, int fr, int fq) const {
        const int v = u.pm; const int nv = v < 4 ? 5632 : (v == 4 ? 2304 : 3328); const int toff = v < 4 ? 22 * v : (v == 4 ? 88 : 97);
        const size_t base = v < 4 ? (size_t)v * 256 * 5632 : (v == 4 ? (size_t)4 * 256 * 5632 : (size_t)4 * 256 * 5632 + (size_t)256 * 2304);
#pragma unroll
        for (int bj = 0; bj < 2; ++bj) {
            const int col0 = (u.pn - toff) * 256 + bj * 128 + wc * 32 + 8 * fq;
#pragma unroll
            for (int ai = 0; ai < 2; ++ai)
#pragma unroll
                for (int m = 0; m < 4; ++m) {
                    const int row = ai * 128 + wr * 64 + m * 16 + fr;
                    float vv[8];
#pragma unroll
                    for (int j = 0; j < 4; ++j) { vv[j] = acc[ai][bj][m][0][j]; vv[4 + j] = acc[ai][bj][m][1][j]; }
                    st8(cb + base + (size_t)row * nv + col0, vv);
                }
        }
    }
};
struct EpiRes {
    static constexpr bool PERM = true, AFTER_DRAIN = false;
    const float* xin_p; const float* xin_s;
    float* xout;
    const float* gate;
    const float* pscale;
    const float* ngain; const float* nscale;
    bf16_t* an; float* rss;
    const float* fgain; unsigned* pcnt;
    __device__ __forceinline__ void operator()(const f32x4 (&acc)[2][2][4][2], const Unit& u, int wr, int wc, int fr, int fq) const {
        const int bi = u.pm >> 3;
        float gt[2][8], gn[2][8];
#pragma unroll
        for (int bj = 0; bj < 2; ++bj) {
            const int col0 = u.pn * 256 + bj * 128 + wc * 32 + 8 * fq;
            ld8(gate + (size_t)bi * E_MODLD + col0, gt[bj]);
            if (pscale) { float ps[8]; ld8(pscale + col0, ps);
#pragma unroll
                for (int j = 0; j < 8; ++j) gt[bj][j] *= ps[j]; }
            if (ngain) { float ns[8]; ld8(ngain + col0, gn[bj]); ld8(nscale + (size_t)bi * E_MODLD + col0, ns);
#pragma unroll
                for (int j = 0; j < 8; ++j) gn[bj][j] *= (1.0f + ns[j]); }
        }
#pragma unroll
        for (int ai = 0; ai < 2; ++ai)
#pragma unroll
            for (int m = 0; m < 4; ++m) {
                const int row = u.pm * 256 + ai * 128 + wr * 64 + m * 16 + fr;
                float ss = 0.f;
#pragma unroll
                for (int bj = 0; bj < 2; ++bj) {
                    const int col0 = u.pn * 256 + bj * 128 + wc * 32 + 8 * fq;
                    float xo[8], xn[8];
                    ld8(xin_p + (size_t)row * 1024 + col0, xo);
#pragma unroll
                    for (int j = 0; j < 4; ++j) { xn[j] = xo[j] + gt[bj][j] * acc[ai][bj][m][0][j]; xn[4 + j] = xo[4 + j] + gt[bj][4 + j] * acc[ai][bj][m][1][j]; }
                    if (fgain) st8(xout + (size_t)row * 1024 + col0, xn);
                    else { __builtin_nontemporal_store((f32x4){xn[0], xn[1], xn[2], xn[3]}, (f32x4*)(xout + (size_t)row * 1024 + col0)); __builtin_nontemporal_store((f32x4){xn[4], xn[5], xn[6], xn[7]}, (f32x4*)(xout + (size_t)row * 1024 + col0 + 4)); }
#pragma unroll
                    for (int j = 0; j < 8; ++j) ss += xn[j] * xn[j];
                    if (ngain) { float o[8];
#pragma unroll
                        for (int j = 0; j < 8; ++j) o[j] = xn[j] * gn[bj][j];
                        st8bf(an + (size_t)row * 1024 + col0, o); }
                }
                ss += __shfl_xor(ss, 16); ss += __shfl_xor(ss, 32);
                if (fq == 0) atomicAdd(rss + row, ss);
                if (m & 1) asm volatile("" ::: "memory");
            }
        if (fgain) {
            asm volatile("s_waitcnt vmcnt(0)" ::: "memory");
            unsigned* cw = pcnt + 64 * u.pm;
            if (fr == 0 && fq == 0) __hip_atomic_fetch_add(cw, 1u, __ATOMIC_RELAXED, __HIP_MEMORY_SCOPE_AGENT);
            { unsigned sp = 0; while (__hip_atomic_load(cw, __ATOMIC_RELAXED, __HIP_MEMORY_SCOPE_AGENT) < 32u) { __builtin_amdgcn_s_sleep(1); if (++sp > (1u << 20)) break; } }
            __builtin_amdgcn_fence(__ATOMIC_ACQUIRE, "agent");
            asm volatile("s_waitcnt vmcnt(0)" ::: "memory");
            float fg[2][8];
#pragma unroll
            for (int bj = 0; bj < 2; ++bj) ld8(fgain + u.pn * 256 + bj * 128 + wc * 32 + 8 * fq, fg[bj]);
#pragma unroll
            for (int ai = 0; ai < 2; ++ai)
#pragma unroll
                for (int m = 0; m < 4; ++m) {
                    const int row = u.pm * 256 + ai * 128 + wr * 64 + m * 16 + fr;
                    const float rinv = __builtin_amdgcn_rsqf(__hip_atomic_load(rss + row, __ATOMIC_RELAXED, __HIP_MEMORY_SCOPE_AGENT) * (1.0f / 1024.0f) + 1e-6f);
#pragma unroll
                    for (int bj = 0; bj < 2; ++bj) {
                        const int col0 = u.pn * 256 + bj * 128 + wc * 32 + 8 * fq;
                        float xn[8]; ld8(xout + (size_t)row * 1024 + col0, xn);
#pragma unroll
                        for (int j = 0; j < 8; ++j) xn[j] = xn[j] * rinv * fg[bj][j];
                        st8(xout + (size_t)row * 1024 + col0, xn);
                    }
                    if (m & 1) asm volatile("" ::: "memory");
                }
        }
    }
};
struct EpiFfnIn {
    static constexpr bool PERM = true, AFTER_DRAIN = false;
    const float* rss; const float* cb;
    const float* cw; const float* cbv;
    const float* cstate;
    bf16_t* act;
    float* hg; float* hu; float* tg;
    float* conv_p; float* conv_s;
    EpiRide ride;
    __device__ __forceinline__ void operator()(const f32x4 (&acc)[2][2][4][2], const Unit& u, int wr, int wc, int fr, int fq) const {
        const bool prompt = u.pm < 64;
        const int rL = u.pm * 22 + u.pn; const bool rdo = rL < ride.nunits; f32x4 rv_[1]; const f32x4* rs_ = nullptr; f32x4* rd_ = nullptr; unsigned re_ = 0u, rn_ = 0u;
        if (rdo) ride.load<1>(rL, (wr * 4 + wc) * 64 + fq * 16 + fr, rv_, rs_, rd_, re_, rn_);
        float rv[2][4];
#pragma unroll
        for (int ai = 0; ai < 2; ++ai)
#pragma unroll
            for (int m = 0; m < 4; ++m) rv[ai][m] = row_rinv(rss, u.pm * 256 + ai * 128 + wr * 64 + m * 16 + fr);
#pragma unroll
        for (int n = 0; n < 2; ++n) {
            const int gc0 = u.pn * 128 + wc * 32 + 8 * fq + 4 * n;
            const int cc0 = u.pn * 256 + wc * 32 + 8 * fq + 4 * n;
            const f32x4 w0 = *(const f32x4*)(cw + gc0), w1 = *(const f32x4*)(cw + E_DFF + gc0), w2 = *(const f32x4*)(cw + 2 * E_DFF + gc0), bb = *(const f32x4*)(cbv + gc0);
            if (prompt) {
                const int bi = u.pm >> 3;
                const f32x4 cg = *(const f32x4*)(cb + (size_t)bi * 5632 + cc0), cu = *(const f32x4*)(cb + (size_t)bi * 5632 + cc0 + 128);
#pragma unroll
                for (int ai = 0; ai < 2; ++ai) {
                    f32x4 gp = {0.f, 0.f, 0.f, 0.f};
#pragma unroll
                    for (int m = 0; m < 4; ++m) {
                        const int row = u.pm * 256 + ai * 128 + wr * 64 + m * 16 + fr;
                        const float rinv = rv[ai][m];
                        const f32x4 g = acc[ai][0][m][n] * rinv + cg, uu = acc[ai][1][m][n] * rinv + cu;
                        f32x4 a;
#pragma unroll
                        for (int j = 0; j < 4; ++j) {
                            const float r1c = dpp_ror1(g[j]), r2c = dpp_ror2(g[j]), r1p = dpp_ror1(gp[j]), r2p = dpp_ror2(gp[j]);
                            const float gm1 = fr >= 1 ? r1c : r1p, gm2 = fr >= 2 ? r2c : r2p;
                            a[j] = w0[j] * gm2 + w1[j] * gm1 + w2[j] * g[j] + bb[j];
                        }
                        const f32x2 e0 = gelu_pk((f32x2){a[0], a[1]}), e1 = gelu_pk((f32x2){a[2], a[3]});
                        const int strip = row >> 6;
                        if (m > 0 || fr >= 2) { u32x2 w; w.x = cvt_pk_bf16(e0.x * uu[0], e0.y * uu[1]); w.y = cvt_pk_bf16(e1.x * uu[2], e1.y * uu[3]); *(u32x2*)(act + (size_t)row * E_DFF + gc0) = w; }
                        if (m == 0 && fr < 2) { *(f32x4*)(hg + ((size_t)strip * 2 + fr) * E_DFF + gc0) = g; *(f32x4*)(hu + ((size_t)strip * 2 + fr) * E_DFF + gc0) = uu; }
                        if (m == 3 && fr >= 14) { *(f32x4*)(tg + ((size_t)strip * 2 + (fr - 14)) * E_DFF + gc0) = g;
                            if ((strip & 31) == 31) *(f32x4*)(conv_p + ((size_t)bi * 2 + (fr - 14)) * E_DFF + gc0) = g; }
                        gp = g;
                        asm volatile("" ::: "memory");
                    }
                }
            } else {
#pragma unroll
                for (int ai = 0; ai < 2; ++ai)
#pragma unroll
                    for (int m = 0; m < 4; ++m) {
                        const int row = u.pm * 256 + ai * 128 + wr * 64 + m * 16 + fr;
                        const int rs = row - E_MP, b = rs >> 2, t = rs & 3, bi = 8 + b;
                        const float rinv = rv[ai][m];
                        const f32x4 cg = *(const f32x4*)(cb + (size_t)bi * 5632 + cc0), cu = *(const f32x4*)(cb + (size_t)bi * 5632 + cc0 + 128);
                        const f32x4 s0 = *(const f32x4*)(cstate + ((size_t)b * 2 + 0) * E_DFF + gc0), s1 = *(const f32x4*)(cstate + ((size_t)b * 2 + 1) * E_DFF + gc0);
                        const f32x4 g = acc[ai][0][m][n] * rinv + cg, uu = acc[ai][1][m][n] * rinv + cu;
                        f32x4 a;
#pragma unroll
                        for (int j = 0; j < 4; ++j) {
                            const float r1c = dpp_ror1(g[j]), r2c = dpp_ror2(g[j]);
                            const float gm1 = t >= 1 ? r1c : s1[j], gm2 = t >= 2 ? r2c : (t == 1 ? s1[j] : s0[j]);
                            a[j] = w0[j] * gm2 + w1[j] * gm1 + w2[j] * g[j] + bb[j];
                        }
                        const f32x2 e0 = gelu_pk((f32x2){a[0], a[1]}), e1 = gelu_pk((f32x2){a[2], a[3]});
                        { u32x2 w; w.x = cvt_pk_bf16(e0.x * uu[0], e0.y * uu[1]); w.y = cvt_pk_bf16(e1.x * uu[2], e1.y * uu[3]); *(u32x2*)(act + (size_t)row * E_DFF + gc0) = w; }
                        if (t >= 2) *(f32x4*)(conv_s + ((size_t)b * 2 + (t - 2)) * E_DFF + gc0) = g;
                        asm volatile("" ::: "memory");
                    }
            }
        }
        if (rdo) ride.store<1>(rv_, rd_, re_, rn_);
    }
};
struct EpiQkv {
    static constexpr bool PERM = true, AFTER_DRAIN = false;
    const float* rss; const float* cb;
    bf16_t* qkv;
    float* out;
    EpiRide ride;
    __device__ __forceinline__ void operator()(const f32x4 (&acc)[2][2][4][2], const Unit& u, int wr, int wc, int fr, int fq) const {
        const int rL = u.pm * 9 + u.pn; const bool rdo = rL < ride.nunits; f32x4 rv_[4]; const f32x4* rs_ = nullptr; f32x4* rd_ = nullptr; unsigned re_ = 0u, rn_ = 0u;
        if (rdo) ride.load<4>(rL, (wr * 4 + wc) * 64 + fq * 16 + fr, rv_, rs_, rd_, re_, rn_);
        const int sec = u.pn / 3, g = u.pn % 3, W = 128 << (2 * g);
        bf16_t* dst = qkv + (size_t)sec * ((WS_KB - WS_QB) / 2);
        const size_t offp = g == 0 ? O_W1P : (g == 1 ? O_W2P : O_W3P), offs = g == 0 ? O_W1S : (g == 1 ? O_W2S : O_W3S);
        float* wp = out + offp; float* ws = out + offs;
        const float sc = sec == 0 ? 0.125f : 1.0f;
        const bool prompt = u.pm < 64;
        float rv[2][4], cbv[2][8];
#pragma unroll
        for (int ai = 0; ai < 2; ++ai)
#pragma unroll
            for (int m = 0; m < 4; ++m) rv[ai][m] = row_rinv(rss, u.pm * 256 + ai * 128 + wr * 64 + m * 16 + fr) * sc;
#pragma unroll
        for (int bj = 0; bj < 2; ++bj) ld8(cb + (size_t)(prompt ? (u.pm >> 3) : 0) * 2304 + u.pn * 256 + bj * 128 + wc * 32 + 8 * fq, cbv[bj]);
#pragma unroll
        for (int ai = 0; ai < 2; ++ai)
#pragma unroll
            for (int m = 0; m < 4; ++m) {
                const int row = u.pm * 256 + ai * 128 + wr * 64 + m * 16 + fr;
                const int bi = prompt ? (u.pm >> 3) : 8 + ((row - E_MP) >> 2);
                const float rinv = rv[ai][m];
#pragma unroll
                for (int bj = 0; bj < 2; ++bj) {
                    const int lc = bj * 128 + wc * 32 + 8 * fq;
                    float c8[8], v[8]; if (prompt) {
#pragma unroll
                        for (int j = 0; j < 8; ++j) c8[j] = cbv[bj][j]; } else ld8(cb + (size_t)bi * 2304 + u.pn * 256 + lc, c8);
#pragma unroll
                    for (int j = 0; j < 4; ++j) { v[j] = rinv * acc[ai][bj][m][0][j] + sc * c8[j]; v[4 + j] = rinv * acc[ai][bj][m][1][j] + sc * c8[4 + j]; }
                    st8bf(dst + (size_t)row * 768 + g * 256 + lc, v);
                    if (sec > 0) {
                        if (prompt) { const int t = row & 2047; if (t >= 2048 - W) st8(wp + (((size_t)bi * W + (t - (2048 - W))) * 2 + (sec - 1)) * 256 + lc, v); }
                        else { const int rs = row - E_MP, b = rs >> 2, t = rs & 3; st8(ws + (((size_t)b * W + (W - 4 + t)) * 2 + (sec - 1)) * 256 + lc, v); }
                    }
                }
                asm volatile("" ::: "memory");
            }
        if (rdo) ride.store<4>(rv_, rd_, re_, rn_);
    }
};
struct EpiGlaIn {
    static constexpr bool PERM = true, AFTER_DRAIN = false;
    const float* rss; const float* cb;
    bf16_t* base;
    float* gd;
    EpiRide ride;
    __device__ __forceinline__ void operator()(const f32x4 (&acc)[2][2][4][2], const Unit& u, int wr, int wc, int fr, int fq) const {
        const int rL = u.pm * 13 + u.pn; const bool rdo = rL < ride.nunits; f32x4 rv_[4]; const f32x4* rs_ = nullptr; f32x4* rd_ = nullptr; unsigned re_ = 0u, rn_ = 0u;
        if (rdo) ride.load<4>(rL, (wr * 4 + wc) * 64 + fq * 16 + fr, rv_, rs_, rd_, re_, rn_);
        const int pn = u.pn;
        const size_t doff = pn < 2 ? 0 : (pn < 4 ? (WS_GK - WS_GQ) / 2 : (pn < 8 ? (WS_GV - WS_GQ) / 2 : (WS_GR - WS_GQ) / 2));
        const int ld = pn < 4 ? 512 : 1024, tcol = (pn < 2 ? pn : (pn < 4 ? pn - 2 : (pn < 8 ? pn - 4 : pn - 8))) * 256;
        bf16_t* dst = base + doff;
        const float sc = pn < 2 ? 0.08838834764831845f : 1.0f;
        const bool prompt = u.pm < 64;
        float rv[2][4], cbv[2][8];
#pragma unroll
        for (int ai = 0; ai < 2; ++ai)
#pragma unroll
            for (int m = 0; m < 4; ++m) rv[ai][m] = row_rinv(rss, u.pm * 256 + ai * 128 + wr * 64 + m * 16 + fr) * sc;
#pragma unroll
        for (int bj = 0; bj < 2; ++bj) ld8(cb + (size_t)(prompt ? (u.pm >> 3) : 0) * 3328 + pn * 256 + bj * 128 + wc * 32 + 8 * fq, cbv[bj]);
#pragma unroll
        for (int ai = 0; ai < 2; ++ai)
#pragma unroll
            for (int m = 0; m < 4; ++m) {
                const int row = u.pm * 256 + ai * 128 + wr * 64 + m * 16 + fr;
                const int bi = prompt ? (u.pm >> 3) : 8 + ((row - E_MP) >> 2);
                const float rinv = rv[ai][m];
#pragma unroll
                for (int bj = 0; bj < 2; ++bj) {
                    const int lc = bj * 128 + wc * 32 + 8 * fq;
                    float c8[8], v[8]; if (prompt) {
#pragma unroll
                        for (int j = 0; j < 8; ++j) c8[j] = cbv[bj][j]; } else ld8(cb + (size_t)bi * 3328 + pn * 256 + lc, c8);
#pragma unroll
                    for (int j = 0; j < 4; ++j) { v[j] = rinv * acc[ai][bj][m][0][j] + sc * c8[j]; v[4 + j] = rinv * acc[ai][bj][m][1][j] + sc * c8[4 + j]; }
                    if (pn < 12) st8bf(dst + (size_t)row * ld + tcol + lc, v);
                    else if (lc < 16) st8(gd + (size_t)row * 16 + lc, v);
                }
                asm volatile("" ::: "memory");
            }
        if (rdo) ride.store<4>(rv_, rd_, re_, rn_);
    }
};
}
constexpr int RING_OFF = 0, RING_BYTES = 133120;
constexpr int LDSCTL_OFF = RING_BYTES, MISC_OFF = LDSCTL_OFF + 320;
constexpr int LDS_BYTES = 147456;
constexpr int NWAVES = 8;

#define XB_TMO      128
#define XB_XCNT(j)  (256  + 64 * (j))
#define XB_XSUB(j)  (1280 + 64 * (j))
#define XB_XGEN(j)  (2304 + 64 * (j))
#define XB_TOP      3328
#define XB_TOPGEN   3392
#define XCD_BAR_WORDS 3456
#define XB_SPIN_CAP (1u << 18)
__device__ __forceinline__ unsigned xb_ld(unsigned* p)              { return __hip_atomic_load(p, __ATOMIC_RELAXED, __HIP_MEMORY_SCOPE_AGENT); }
__device__ __forceinline__ unsigned xb_add(unsigned* p, unsigned v) { return __hip_atomic_fetch_add(p, v, __ATOMIC_RELAXED, __HIP_MEMORY_SCOPE_AGENT); }
__device__ __forceinline__ unsigned xb_xcc_id() { return (unsigned)__builtin_amdgcn_s_getreg((3 << 11) | 20) & 0xFu; }
#define XB_SPIN(cond, bar) do { unsigned _sp = 0; while (cond) { __builtin_amdgcn_s_sleep(1); \
    if ((++_sp & 255u) == 0u) { if (xb_ld(&(bar)[XB_TMO])) break; if (_sp > XB_SPIN_CAP) { atomicAdd(&(bar)[XB_TMO], 1u); break; } } } } while (0)
struct XcdBarrier { unsigned* bar; unsigned x; volatile LAS unsigned* st; };
__device__ __forceinline__ XcdBarrier xcd_barrier_post(unsigned* bar, volatile LAS unsigned* st, int tid) {
    XcdBarrier b; b.bar = bar; b.x = xb_xcc_id(); b.st = st;
    if (tid == 0) (void)xb_add(&bar[XB_XCNT(b.x)], 1u);
    return b;
}
__device__ __forceinline__ void xcd_barrier_complete(unsigned* bar, unsigned x, unsigned& nloc, unsigned& nx) {
    const unsigned G = gridDim.x * gridDim.y * gridDim.z;
    unsigned sum, cnt, mine, sp = 0u;
    for (;;) {
        sum = 0u; cnt = 0u; mine = 0u;
#pragma unroll
        for (unsigned j = 0; j < 16; ++j) { const unsigned c = xb_ld(&bar[XB_XCNT(j)]); sum += c; cnt += (c > 0u) ? 1u : 0u; mine = (j == x) ? c : mine; }
        if (sum == G) break;
        __builtin_amdgcn_s_sleep(1);
        if ((++sp & 255u) == 0u) { if (xb_ld(&bar[XB_TMO])) break; if (sp > XB_SPIN_CAP) { atomicAdd(&bar[XB_TMO], 1u); break; } }
    }
    nloc = mine > 0u ? mine : 1u; nx = cnt > 0u ? cnt : 1u;
}
__device__ __forceinline__ void xcd_barrier(const XcdBarrier& b, int tid) {
    asm volatile("s_waitcnt vmcnt(0)" ::: "memory");
    __syncthreads();
    if (tid == 0) {
        unsigned* bar = b.bar;
        __builtin_amdgcn_s_waitcnt(0);
        unsigned nloc = b.st[0], nx = b.st[1];
        if (nloc == 0u) { xcd_barrier_complete(bar, b.x, nloc, nx); b.st[0] = nloc; b.st[1] = nx; }
        const unsigned old = xb_add(&bar[XB_XSUB(b.x)], 1u);
        const unsigned gen = old / nloc;
        if (old + 1u == (gen + 1u) * nloc) {
            __builtin_amdgcn_fence(__ATOMIC_RELEASE, "agent");
            asm volatile("s_waitcnt vmcnt(0)" ::: "memory");
            const unsigned og = xb_add(&bar[XB_TOP], 1u);
            const unsigned tg = og / nx;
            if (og + 1u == (tg + 1u) * nx) xb_add(&bar[XB_TOPGEN], 1u);
            else XB_SPIN(xb_ld(&bar[XB_TOPGEN]) == tg, bar);
            __builtin_amdgcn_fence(__ATOMIC_ACQUIRE, "agent");
            xb_add(&bar[XB_XGEN(b.x)], 1u);
            asm volatile("s_waitcnt vmcnt(0)" ::: "memory");
        } else {
            XB_SPIN(xb_ld(&bar[XB_XGEN(b.x)]) == gen, bar);
            __builtin_amdgcn_fence(__ATOMIC_ACQUIRE, "agent");
            asm volatile("s_waitcnt vmcnt(0)" ::: "memory");
        }
    }
    __syncthreads();
}

struct Frame {
    LAS unsigned char* lds;
    int tid, lane, wave, G, bid;
    const __attribute__((address_space(4))) unsigned char* ka;
    __device__ __forceinline__ const float* inp(int k) const { return (const float*)(*(const GAS float* const __attribute__((address_space(4)))*)(ka + 8 * k)); }
    GAS float* out_g; GAS unsigned char* ws_g;
};
#define F_WS ((unsigned char*)F.ws_g)
#define F_OUT ((float*)F.out_g)
#define WSP(T, off) ((T*)(F_WS + (off)))
#define RIDE_LOAD(N, V, CB, E0) do { _Pragma("unroll") for (int u_ = 0; u_ < (N); ++u_) { const unsigned e_ = (unsigned)(E0) + (unsigned)(u_ * 512) + (unsigned)F.tid; (V)[u_] = __builtin_nontemporal_load((CB).src + (e_ < (CB).n ? e_ : (CB).n - 1u)); } } while (0)
#define RIDE_STORE(N, V, CB, E0) do { _Pragma("unroll") for (int u_ = 0; u_ < (N); ++u_) { const unsigned e_ = (unsigned)(E0) + (unsigned)(u_ * 512) + (unsigned)F.tid; if (e_ < (CB).n) __builtin_nontemporal_store((V)[u_], (CB).dst + e_); } } while (0)

constexpr unsigned CP_SLICE_F4 = 16384u, CP_NSTATIC = 1513u;
struct CpBase { const f32x4* src; f32x4* dst; unsigned n; };
__device__ __forceinline__ CpBase copy_base(Frame& F, unsigned s) {
    const unsigned b = s >> 4, k = s & 15u, per_b = 2044u * 128u;
    CpBase c; c.src = (const f32x4*)F.inp(5) + (size_t)b * (2048 * 128) + 512 + (size_t)k * CP_SLICE_F4; c.dst = (f32x4*)(F_OUT + O_W3S) + (size_t)b * (2048 * 128) + (size_t)k * CP_SLICE_F4;
    c.n = per_b - k * CP_SLICE_F4 < CP_SLICE_F4 ? per_b - k * CP_SLICE_F4 : CP_SLICE_F4; return c;
}


__device__ __forceinline__ void p0_transpose_item(const float* W, int K, int N, bf16* WT, int ldt, int drow0, LAS float* scr, int kb, int nb, int lane) {
    const int k0 = 64 * kb, n0 = 32 * nb;
#pragma unroll
    for (int i = 0; i < 32; ++i) { const int kk = 2 * i + (lane >> 5); const int n = n0 + (lane & 31); scr[kk * 33 + (lane & 31)] = (n < N) ? W[(size_t)(k0 + kk) * N + n] : 0.f; }
    LDS_WAIT(); asm volatile("" ::: "memory");
    const int c = lane & 7;
#pragma unroll
    for (int j = 0; j < 4; ++j) { const int n = (lane >> 3) + 8 * j; const LAS float* s = scr + (8 * c) * 33 + n;
        v4u o; o.x = pk2(s[0 * 33], s[1 * 33]); o.y = pk2(s[2 * 33], s[3 * 33]); o.z = pk2(s[4 * 33], s[5 * 33]); o.w = pk2(s[6 * 33], s[7 * 33]);
        *(v4u*)(WT + (size_t)(drow0 + n) * ldt + k0 + 8 * c) = o; }
    LDS_WAIT(); asm volatile("" ::: "memory");
}
__device__ __forceinline__ void p0_prologue(Frame& F) {
    LAS float* scr = (LAS float*)(F.lds + RING_OFF + F.wave * 16384);
    const int gw = F.bid * NWAVES + F.wave, NGW = F.G * NWAVES;
    constexpr int I_FI = 16 * 176, I_QKV = 16 * 72, I_GI = 16 * 97, I_FD = 44 * 32, I_AO = 12 * 32, I_GO = 16 * 32, I_PW = 4 * 8;
    constexpr int NITEMS = 4 * I_FI + I_QKV + I_GI + 4 * I_FD + I_AO + I_GO + 8 * I_PW;
    for (int it = gw; it < NITEMS; it += NGW) {
        int r = it;
        if (r < 4 * I_FI) { const int l = r / I_FI, q = r % I_FI, kb = q / 176, nb = q % 176, n0 = 32 * nb, half = n0 / DFF, jn = n0 % DFF;
            p0_transpose_item(F.inp(24) + (size_t)l * 1024 * 5632, 1024, 5632, WSP(bf16, WS_WNF) + (size_t)l * 5632 * 1024, 1024, (jn / 128) * 256 + half * 128 + (jn % 128), scr, kb, nb, F.lane); continue; }
        r -= 4 * I_FI;
        if (r < I_QKV) { const int kb = r / 72, nb = r % 72; p0_transpose_item(F.inp(17), 1024, 2304, WSP(bf16, WS_WNF) + (size_t)22528 * 1024, 1024, 32 * nb, scr, kb, nb, F.lane); continue; }
        r -= I_QKV;
        if (r < I_GI) { const int kb = r / 97, nb = r % 97; p0_transpose_item(F.inp(19), 1024, 3088, WSP(bf16, WS_WNF) + (size_t)24832 * 1024, 1024, 32 * nb, scr, kb, nb, F.lane); continue; }
        r -= I_GI;
        if (r < 4 * I_FD) { const int l = r / I_FD, q = r % I_FD, kb = q / 32, nb = q % 32; p0_transpose_item(F.inp(27) + (size_t)l * DFF * 1024, DFF, 1024, WSP(bf16, WS_WD) + (size_t)l * 1024 * DFF, DFF, 32 * nb, scr, kb, nb, F.lane); continue; }
        r -= 4 * I_FD;
        if (r < I_AO) { const int kb = r / 32, nb = r % 32; p0_transpose_item(F.inp(18), 768, 1024, WSP(bf16, WS_WAO), 768, 32 * nb, scr, kb, nb, F.lane); continue; }
        r -= I_AO;
        if (r < I_GO) { const int kb = r / 32, nb = r % 32; p0_transpose_item(F.inp(23), 1024, 1024, WSP(bf16, WS_WGO), 1024, 32 * nb, scr, kb, nb, F.lane); continue; }
        r -= I_GO;
        { const int jg = r / I_PW, q = r % I_PW, kb = q / 8, nb = q % 8;
            p0_transpose_item(F.inp(15) + (size_t)jg * 65536, 256, 256, WSP(bf16, WS_WP) + (size_t)(jg >> 2) * 1024 * 256, 256, (jg & 3) * 256 + 32 * nb, scr, kb, nb, F.lane); }
    }
}

__device__ __forceinline__ void mod_direct_phase(Frame& F) {
    LAS bf16* A_l = (LAS bf16*)(F.lds + RING_OFF);
    float* mod = WSP(float, WS_MOD); bf16* sh = WSP(bf16, WS_SH);
    const int fr = F.lane & 15, fq = F.lane >> 4, w = F.wave;
    for (int slab = F.bid; slab < 256; slab += F.G) {
        const int l = slab >> 6, cl0 = (slab & 63) * 96;
        const float* Wl = F.inp(10) + (size_t)l * 1024 * 6144 + cl0 + 16 * w + fr;
        f32x4 acc[9];
#pragma unroll
        for (int rb = 0; rb < 9; ++rb) acc[rb] = (f32x4){0.f, 0.f, 0.f, 0.f};
#pragma unroll 1
        for (int kc = 0; kc < 4; ++kc) {
            asm volatile("" ::: "memory");
            __syncthreads();
#pragma unroll
            for (int q = 0; q < 9; ++q) { const int id = F.tid + 512 * q, row = id >> 5, c8 = (id & 31) * 8; v4u o = {0u, 0u, 0u, 0u};
                if (row < NBI) { const float* src = (row < NBP ? F.inp(8) + (size_t)row * D : F.inp(9) + (size_t)(row - NBP) * D) + 256 * kc + c8;
                    const f32x4 a = *(const f32x4*)src, b = *(const f32x4*)(src + 4); float v[8] = {a[0], a[1], a[2], a[3], b[0], b[1], b[2], b[3]};
#pragma unroll
                    for (int j = 0; j < 8; ++j) v[j] = v[j] / (1.0f + __expf(-v[j]));
                    o.x = pk2(v[0], v[1]); o.y = pk2(v[2], v[3]); o.z = pk2(v[4], v[5]); o.w = pk2(v[6], v[7]); }
                *(LAS v4u*)(A_l + row * 264 + c8) = o; }
            __syncthreads();
            if (w < 6) {
                const float* wp = Wl + (size_t)(256 * kc + 8 * fq) * 6144;
#pragma unroll 1
                for (int kh = 0; kh < 2; ++kh) {
                    float bw[4][8];
#pragma unroll
                    for (int ks = 0; ks < 4; ++ks)
#pragma unroll
                        for (int j = 0; j < 8; ++j) bw[ks][j] = wp[(size_t)(32 * ks + j) * 6144];
#pragma unroll
                    for (int ks = 0; ks < 4; ++ks) {
                        v4u bp; bp.x = pk2(bw[ks][0], bw[ks][1]); bp.y = pk2(bw[ks][2], bw[ks][3]); bp.z = pk2(bw[ks][4], bw[ks][5]); bp.w = pk2(bw[ks][6], bw[ks][7]);
                        const bf16x8 bfrag = __builtin_bit_cast(bf16x8, bp);
#pragma unroll
                        for (int rb = 0; rb < 9; ++rb) { const bf16x8 a = *(const LAS bf16x8*)(A_l + (16 * rb + fr) * 264 + 128 * kh + 32 * ks + 8 * fq); acc[rb] = MFMA16(a, bfrag, acc[rb]); }
                    }
                    wp += (size_t)128 * 6144;
                    asm volatile("" ::: "memory");
                }
            }
        }
        if (w < 6) {
            const int col = cl0 + 16 * w + fr, mi = col >> 10, cc = col & 1023;
            const int variant = (mi == 3) ? l : ((mi == 0 && l == 1) ? 4 : ((mi == 0 && l == 2) ? 5 : -1));
            const float bias = F.inp(11)[l * 6144 + col];
#pragma unroll
            for (int rb = 0; rb < 9; ++rb)
#pragma unroll
                for (int j = 0; j < 4; ++j) { const int row = 16 * rb + 4 * fq + j; const float v = acc[rb][j] + bias;
                    if (row < NBI) mod[(size_t)row * MODLD + l * 6144 + col] = v;
                    if (variant >= 0) sh[((size_t)variant * 256 + row) * 1024 + cc] = (bf16)(pk2(v, 0.f) & 0xffffu); }
        }
    }
}
template <int W, int NNEW, bool SAMPLE>
__device__ __forceinline__ void pool_march(const float* xrow0  , int t0, const float* past  ,
                                           const LAS float* rinv_l, int c0, float G0, float G1, float sh0, float sh1, bf16* drow0  , float* st_out  , int st_first  ) {
    float r0[W], r1[W]; float s0 = 0.f, s1 = 0.f;
#pragma unroll
    for (int j = 0; j < W; ++j) { r0[j] = 0.f; r1[j] = 0.f; }
    constexpr int NTOT = 15 + NNEW, NBLK = (NTOT + 15) / 16;
#define POOL_LOAD(BLK, XV) do { _Pragma("unroll") for (int jj = 0; jj < 16; ++jj) { const int i = (BLK) * 16 + jj < NTOT ? (BLK) * 16 + jj : NTOT - 1;        \
            if (SAMPLE) (XV)[jj] = (i < 15) ? *(const f32x2*)(past + (size_t)i * D + c0) : *(const f32x2*)(xrow0 + (size_t)(i - 15) * D + c0); \
            else { const int t = t0 - 15 + i; (XV)[jj] = *(const f32x2*)(xrow0 + (size_t)(t >= 0 ? t : 0) * D + c0); } } } while (0)
    f32x2 xa[16], xb[16]; POOL_LOAD(0, xa);
#pragma unroll
    for (int blk = 0; blk < NBLK; ++blk) {
        if (blk + 1 < NBLK) { if (blk & 1) POOL_LOAD(blk + 1, xa); else POOL_LOAD(blk + 1, xb); }
        const f32x2 (&xv)[16] = (blk & 1) ? xb : xa;
#pragma unroll
        for (int jj = 0; jj < 16; ++jj) { const int i = blk * 16 + jj;
            if (i < NTOT) {
                float h0 = 0.f, h1 = 0.f;
                if (SAMPLE) { if (i < 15) { h0 = xv[jj].x; h1 = xv[jj].y; } else { const float r = rinv_l[i - 15]; h0 = xv[jj].x * r * G0 + sh0; h1 = xv[jj].y * r * G1 + sh1; } }
                else { const int t = t0 - 15 + i; if (t >= 0) { const float r = rinv_l[i]; h0 = xv[jj].x * r * G0 + sh0; h1 = xv[jj].y * r * G1 + sh1; } }
                const int slot = i % W;
                s0 += h0 - r0[slot]; r0[slot] = h0; s1 += h1 - r1[slot]; r1[slot] = h1;
                if (i >= 15) {
                    const int tn = i - 15;
                    float cnt = (float)W;
                    if (!SAMPLE) { const int t = t0 + tn; cnt = (float)(t + 1 < W ? t + 1 : W); }
                    const float ic = 1.0f / cnt;
                    *(unsigned*)(drow0 + (size_t)tn * D + c0) = pk2(s0 * ic - h0, s1 * ic - h1);
                    if (SAMPLE) { if (st_out) *(f32x2*)(st_out + (size_t)(11 + tn) * D + c0) = (f32x2){h0, h1}; }
                    else if (st_out) { const int t = t0 + tn; if (t >= st_first) *(f32x2*)(st_out + (size_t)(t - st_first) * D + c0) = (f32x2){h0, h1}; }
                } else if (SAMPLE) {
                    if (st_out && i >= 4) *(f32x2*)(st_out + (size_t)(i - 4) * D + c0) = (f32x2){h0, h1};
                }
            } }
    }
}
__device__ __forceinline__ float row_sumsq(const float* xr, int lane) {
    float s = 0.f;
#pragma unroll
    for (int j = 0; j < 4; ++j) { const f32x4 v = *(const f32x4*)(xr + 4 * lane + 256 * j); s += (v[0] * v[0] + v[1] * v[1]) + (v[2] * v[2] + v[3] * v[3]); }
    return wave_sum(s);
}
#undef POOL_LOAD
__device__ __forceinline__ void pool_diff_phase(Frame& F, int l, int j, const float* xp, const float* xs  , const float* rs  , bool bal  ) {
    LAS float* rinv_l = (LAS float*)(F.lds + RING_OFF);
    const float* mod = WSP(float, WS_MOD);
    bf16* dp = WSP(bf16, WS_DP);
    const int c0 = 2 * F.tid, grp = F.tid >> 7;
    const float ng0 = F.inp(12)[(l * 2 + 0) * D + c0], ng1 = F.inp(12)[(l * 2 + 0) * D + c0 + 1];
    const int nu = bal ? (F.bid < 110 ? 0 : (F.bid < 220 ? 2 : 1)) : (NBP * 32 - F.bid + F.G - 1) / F.G;
    for (int ku = 0; ku < nu; ++ku) {
        const int uidx = bal ? (ku == 0 ? F.bid : F.bid - 110) : F.bid + ku * F.G;
        const int b = uidx >> 5, ch = uidx & 31, t0 = 64 * ch;
        const float* xseq = xp + (size_t)b * TP * D;
        const bool ride = (F.G == 256); const CpBase cpb = copy_base(F, 512u + (unsigned)uidx); f32x4 cpv[8];
        if (ride) { asm volatile("" : "+v"(F.tid)); RIDE_LOAD(8, cpv, cpb, j * 8192); }
        LDS_BARRIER();
        if (rs) { if (F.tid < 79) { const int t = t0 - 15 + F.tid; rinv_l[F.tid] = t >= 0 ? __builtin_amdgcn_rsqf(rs[(size_t)b * TP + t] * (1.0f / D) + EPS) : 0.f; } }
        else {
#pragma unroll
            for (int hf = 0; hf < 2; ++hf) {
                f32x4 xr[5][4];
#pragma unroll
                for (int k = 0; k < 5; ++k) { const int i = F.wave + 8 * (5 * hf + k), ic = i < 79 ? i : 78, t = t0 - 15 + ic; const float* xrp = xseq + (size_t)(t >= 0 ? t : 0) * D + 4 * F.lane;
#pragma unroll
                    for (int q = 0; q < 4; ++q) xr[k][q] = *(const f32x4*)(xrp + 256 * q); }
#pragma unroll
                for (int k = 0; k < 5; ++k) { const int i = F.wave + 8 * (5 * hf + k), t = t0 - 15 + i; float sq = 0.f;
#pragma unroll
                    for (int q = 0; q < 4; ++q) { const f32x4 v = xr[k][q]; sq += (v[0] * v[0] + v[1] * v[1]) + (v[2] * v[2] + v[3] * v[3]); }
                    sq = wave_sum(sq);
                    const float r = t >= 0 ? __builtin_amdgcn_rsqf(sq * (1.0f / D) + EPS) : 0.f;
                    if (F.lane == 0 && i < 79) rinv_l[i] = r; }
            }
        }
        LDS_BARRIER();
        if (ride) { asm volatile("" : "+v"(F.tid)); RIDE_STORE(8, cpv, cpb, j * 8192); asm volatile("" : "+v"(F.tid)); RIDE_LOAD(8, cpv, cpb, j * 8192 + 4096); }
        const float* mrow = mod + (size_t)b * MODLD + l * 6144;
        const float G0 = ng0 * (1.0f + mrow[1024 + c0]), G1 = ng1 * (1.0f + mrow[1024 + c0 + 1]), sh0 = mrow[c0], sh1 = mrow[c0 + 1];
        bf16* drow0 = dp + ((size_t)b * TP + t0) * D;
        float* st = (ch == 31) ? F_OUT + O_POOLP + ((size_t)j * NBP + b) * 15 * D : nullptr;
        if (grp == 0)      pool_march<2, 64, false>(xseq, t0, nullptr, rinv_l, c0, G0, G1, sh0, sh1, drow0, st, TP - 15);
        else if (grp == 1) pool_march<4, 64, false>(xseq, t0, nullptr, rinv_l, c0, G0, G1, sh0, sh1, drow0, st, TP - 15);
        else if (grp == 2) pool_march<8, 64, false>(xseq, t0, nullptr, rinv_l, c0, G0, G1, sh0, sh1, drow0, st, TP - 15);
        else               pool_march<16, 64, false>(xseq, t0, nullptr, rinv_l, c0, G0, G1, sh0, sh1, drow0, st, TP - 15);
        if (ride) { asm volatile("" : "+v"(F.tid)); RIDE_STORE(8, cpv, cpb, j * 8192 + 4096); }
    }
    for (int b = bal ? (F.bid < 110 ? F.bid : (F.bid >= 220 && F.bid < 238 ? F.bid - 110 : -1)) : (F.G >= 2 * NBS ? F.bid - NBS : F.bid); b < NBS; b += F.G) {
        if (b < 0) continue;
        const float* xrow0 = xs + ((size_t)MP + 4 * b) * D;
        __syncthreads();
        if (rs) { if (F.tid < 4) rinv_l[F.tid] = __builtin_amdgcn_rsqf(rs[(size_t)MP + 4 * b + F.tid] * (1.0f / D) + EPS); }
        else if (F.wave < 4) { const float r = __builtin_amdgcn_rsqf(row_sumsq(xrow0 + (size_t)F.wave * D, F.lane) * (1.0f / D) + EPS); if (F.lane == 0) rinv_l[F.wave] = r; }
        __syncthreads();
        const float* mrow = mod + (size_t)(NBP + b) * MODLD + l * 6144;
        const float G0 = ng0 * (1.0f + mrow[1024 + c0]), G1 = ng1 * (1.0f + mrow[1024 + c0 + 1]), sh0 = mrow[c0], sh1 = mrow[c0 + 1];
        const float* past = F.inp(2) + ((size_t)j * NBS + b) * 15 * D;
        bf16* drow0 = dp + ((size_t)MP + 4 * b) * D;
        float* st = F_OUT + O_POOLS + ((size_t)j * NBS + b) * 15 * D;
        if (grp == 0)      pool_march<2, 4, true>(xrow0, 0, past, rinv_l, c0, G0, G1, sh0, sh1, drow0, st, 0);
        else if (grp == 1) pool_march<4, 4, true>(xrow0, 0, past, rinv_l, c0, G0, G1, sh0, sh1, drow0, st, 0);
        else if (grp == 2) pool_march<8, 4, true>(xrow0, 0, past, rinv_l, c0, G0, G1, sh0, sh1, drow0, st, 0);
        else               pool_march<16, 4, true>(xrow0, 0, past, rinv_l, c0, G0, G1, sh0, sh1, drow0, st, 0);
    }
}

__device__ __forceinline__ void ffn_fixup_phase(Frame& F, int l) {
    const float* hg = WSP(float, WS_HG); const float* hu = WSP(float, WS_HU); const float* tg = WSP(float, WS_TG);
    bf16* act = WSP(bf16, WS_ACT);
    const float* cw = F.inp(25) + (size_t)l * 3 * DFF; const float* cbv = F.inp(26) + (size_t)l * DFF;
    for (int s = F.bid; s < 256; s += F.G) {
        const bool first = (s & 31) == 0;
        const size_t sp = (size_t)(first ? s : s - 1);
        float gm2[6], gm1[6], g0[6], g1[6], u0[6], u1[6], w0[6], w1[6], w2[6], bb[6];
#pragma unroll
        for (int k = 0; k < 6; ++k) { const int colr = F.tid + 512 * k, col = colr < DFF ? colr : DFF - 1;
            gm2[k] = tg[(sp * 2 + 0) * DFF + col]; gm1[k] = tg[(sp * 2 + 1) * DFF + col];
            g0[k] = hg[((size_t)s * 2 + 0) * DFF + col]; g1[k] = hg[((size_t)s * 2 + 1) * DFF + col];
            u0[k] = hu[((size_t)s * 2 + 0) * DFF + col]; u1[k] = hu[((size_t)s * 2 + 1) * DFF + col];
            w0[k] = cw[col]; w1[k] = cw[DFF + col]; w2[k] = cw[2 * DFF + col]; bb[k] = cbv[col]; }
#pragma unroll
        for (int k = 0; k < 6; ++k) { const int col = F.tid + 512 * k;
            const float m2 = first ? 0.f : gm2[k], m1 = first ? 0.f : gm1[k];
            const float a0 = pg8::gelu1(w0[k] * m2 + w1[k] * m1 + w2[k] * g0[k] + bb[k]) * u0[k];
            const float a1 = pg8::gelu1(w0[k] * m1 + w1[k] * g0[k] + w2[k] * g1[k] + bb[k]) * u1[k];
            if (col < DFF) { act[(size_t)(64 * s) * DFF + col] = (bf16)(pk2(a0, 0.f) & 0xffffu); act[(size_t)(64 * s + 1) * DFF + col] = (bf16)(pk2(a1, 0.f) & 0xffffu); } }
    }
}


__device__ __forceinline__ int t5_bucket(int dist) {
    if (dist < 16) return dist;
    const float df = (float)dist;
    int large = 16 + (int)(logf(df / 16.0f) / 4.852030263919617f * 16.0f);
    return large < 31 ? large : 31;
}
__device__ __forceinline__ void attn_block(Frame& F, int b, int hs, int g, int rho, int d, int i0) {
    LAS bf16* Ks = (LAS bf16*)(F.lds + RING_OFF);
    LAS bf16* Vt = (LAS bf16*)(F.lds + RING_OFF + 36864);
    const LAS float* bias_l = (const LAS float*)(F.lds + RING_OFF + 72704) + (g * 4 + hs) * 132;
    const bf16* QB = WSP(bf16, WS_QB); const bf16* KB = WSP(bf16, WS_KB); const bf16* VB = WSP(bf16, WS_VB);
    bf16* AO = WSP(bf16, WS_AO); float* LSE = WSP(float, WS_LSE);
    const int colq = g * 256 + hs * 64;
    const int fr = F.lane & 15, fq = F.lane >> 4;
#pragma unroll
    for (int j = 0; j < 4; ++j) {
        const int id = F.tid + 512 * j, key = id >> 3, part = id & 7, ki = i0 - 128 + key;
        v4u kv = {0u, 0u, 0u, 0u}, vv = {0u, 0u, 0u, 0u};
        if (ki >= 0) { const size_t row = (size_t)b * TP + rho + d * ki; kv = *(const v4u*)(KB + row * 768 + colq + part * 8); vv = *(const v4u*)(VB + row * 768 + colq + part * 8); }
        *(LAS v4u*)(Ks + key * 72 + part * 8) = kv;
        LAS bf16* vt = Vt + (part * 8) * 264 + key;
        vt[0 * 264] = (bf16)(vv.x & 0xffffu); vt[1 * 264] = (bf16)(vv.x >> 16); vt[2 * 264] = (bf16)(vv.y & 0xffffu); vt[3 * 264] = (bf16)(vv.y >> 16);
        vt[4 * 264] = (bf16)(vv.z & 0xffffu); vt[5 * 264] = (bf16)(vv.z >> 16); vt[6 * 264] = (bf16)(vv.w & 0xffffu); vt[7 * 264] = (bf16)(vv.w >> 16);
    }
    __syncthreads();
    const int w = F.wave, ql = 16 * w + fr;
    const size_t rowq = (size_t)b * TP + rho + d * (i0 + ql);
    bf16x8 qf[2];
    qf[0] = *(const bf16x8*)(QB + rowq * 768 + colq + 8 * fq); qf[1] = *(const bf16x8*)(QB + rowq * 768 + colq + 32 + 8 * fq);
    float sc[9][4]; float mx = -1e30f;
#pragma unroll
    for (int jt = 0; jt < 9; ++jt) {
        const int tile = w + jt;
        f32x4 acc = {0.f, 0.f, 0.f, 0.f};
#pragma unroll
        for (int s = 0; s < 2; ++s) { const bf16x8 a = *(const LAS bf16x8*)(Ks + (16 * tile + fr) * 72 + 32 * s + 8 * fq); acc = MFMA16(a, qf[s], acc); }
#pragma unroll
        for (int j = 0; j < 4; ++j) { const int kl = 16 * tile + 4 * fq + j, dist = ql + 128 - kl; const bool valid = dist >= 0 && dist <= 128 && (i0 - 128 + kl) >= 0;
            const float v = valid ? acc[j] + bias_l[valid ? dist : 0] : -1e30f; sc[jt][j] = v; mx = v > mx ? v : mx; }
    }
    { const float o1 = __shfl_xor(mx, 16); mx = o1 > mx ? o1 : mx; const float o2 = __shfl_xor(mx, 32); mx = o2 > mx ? o2 : mx; }
    float sum = 0.f;
#pragma unroll
    for (int jt = 0; jt < 9; ++jt)
#pragma unroll
        for (int j = 0; j < 4; ++j) { const float e = __expf(sc[jt][j] - mx); sc[jt][j] = e; sum += e; }
    sum += __shfl_xor(sum, 16); sum += __shfl_xor(sum, 32);
    const float inv = 1.0f / sum, lse = mx + __logf(sum);
    f32x4 o[4];
#pragma unroll
    for (int db = 0; db < 4; ++db) o[db] = (f32x4){0.f, 0.f, 0.f, 0.f};
#pragma unroll
    for (int pp = 0; pp < 5; ++pp) {
        const int ta = w + 2 * pp, tb = ta + 1; const bool hasb = (2 * pp + 1) < 9;
        v4u pb; pb.x = pk2(sc[2 * pp][0] * inv, sc[2 * pp][1] * inv); pb.y = pk2(sc[2 * pp][2] * inv, sc[2 * pp][3] * inv);
        if (hasb) { pb.z = pk2(sc[hasb ? 2 * pp + 1 : 0][0] * inv, sc[hasb ? 2 * pp + 1 : 0][1] * inv); pb.w = pk2(sc[hasb ? 2 * pp + 1 : 0][2] * inv, sc[hasb ? 2 * pp + 1 : 0][3] * inv); } else { pb.z = 0u; pb.w = 0u; }
        const bf16x8 pB = __builtin_bit_cast(bf16x8, pb);
#pragma unroll
        for (int db = 0; db < 4; ++db) {
            const LAS bf16* vr = Vt + (16 * db + fr) * 264 + 4 * fq;
            const v2u lo = *(const LAS v2u*)(vr + 16 * ta); v2u hi = {0u, 0u}; if (hasb) hi = *(const LAS v2u*)(vr + 16 * tb);
            const v4u av = {lo.x, lo.y, hi.x, hi.y};
            o[db] = MFMA16(__builtin_bit_cast(bf16x8, av), pB, o[db]);
        }
    }
#pragma unroll
    for (int db = 0; db < 4; ++db) { v2u ov; ov.x = pk2(o[db][0], o[db][1]); ov.y = pk2(o[db][2], o[db][3]); *(v2u*)(AO + rowq * 768 + colq + 16 * db + 4 * fq) = ov; }
    if (fq == 0) LSE[rowq * 12 + g * 4 + hs] = lse;
    __syncthreads();
}
__device__ __forceinline__ void attn_sample_task(Frame& F, int G, int tok, int hs, LAS float* sc_l, const LAS float* bias_t) {
    const int d = 1 << (2 * G), W = 128 << (2 * G);
    const float* cache = F.inp(3 + G);
    const bf16* QB = WSP(bf16, WS_QB); const bf16* KB = WSP(bf16, WS_KB); const bf16* VB = WSP(bf16, WS_VB);
    bf16* AO = WSP(bf16, WS_AO); float* LSE = WSP(float, WS_LSE);
    const int b = tok >> 2, t = tok & 3;
    const int kq = F.lane >> 4, dl = F.lane & 15, colq = G * 256 + hs * 64;
    const size_t rowq = (size_t)MP + tok;
    f32x4 q4; { const v2u qw = *(const v2u*)(QB + rowq * 768 + colq + 4 * dl); q4 = (f32x4){bflo(qw.x), bfhi(qw.x), bflo(qw.y), bfhi(qw.y)}; }
    const float* crow = cache + ((size_t)b * W - (size_t)(TP - W)) * 512 + hs * 64 + 4 * dl;
    f32x4 kk[33];
    { const int pos = TP + t - kq * d;
      if (pos >= TP) { const v2u kw = *(const v2u*)(KB + ((size_t)MP + 4 * b + (pos - TP)) * 768 + colq + 4 * dl); kk[0] = (f32x4){bflo(kw.x), bfhi(kw.x), bflo(kw.y), bfhi(kw.y)}; }
      else kk[0] = *(const f32x4*)(crow + (size_t)pos * 512); }
    const float* krow = crow + (size_t)(TP + t - kq * d) * 512;
#pragma unroll
    for (int it = 1; it < 32; ++it) kk[it] = *(const f32x4*)(krow - (size_t)it * (size_t)(2048 * d));
    kk[32] = *(const f32x4*)(crow + (size_t)(TP + t - 128 * d) * 512);
    float mx = -1e30f;
    const LAS float* bias_j = bias_t + (G * 4 + hs) * 132 + kq;
#pragma unroll
    for (int it = 0; it < 33; ++it) {
        float s = (q4[0] * kk[it][0] + q4[1] * kk[it][1]) + (q4[2] * kk[it][2] + q4[3] * kk[it][3]);
        s += __shfl_xor(s, 1); s += __shfl_xor(s, 2); s += __shfl_xor(s, 4); s += __shfl_xor(s, 8);
        if (it < 32) { s += bias_j[4 * it]; mx = s > mx ? s : mx; if (dl == 0) sc_l[4 * it + kq] = s; }
        else if (kq == 0) { s += bias_j[128]; mx = s > mx ? s : mx; if (dl == 0) sc_l[128] = s; }
    }
    { const float o1 = __shfl_xor(mx, 16); mx = o1 > mx ? o1 : mx; const float o2 = __shfl_xor(mx, 32); mx = o2 > mx ? o2 : mx; }
    asm volatile("" ::: "memory");
    f32x4 vv[33];
    { const int pos = TP + t - kq * d;
      if (pos >= TP) { const v2u vw = *(const v2u*)(VB + ((size_t)MP + 4 * b + (pos - TP)) * 768 + colq + 4 * dl); vv[0] = (f32x4){bflo(vw.x), bfhi(vw.x), bflo(vw.y), bfhi(vw.y)}; }
      else vv[0] = *(const f32x4*)(crow + (size_t)pos * 512 + 256); }
#pragma unroll
    for (int it = 1; it < 32; ++it) vv[it] = *(const f32x4*)(krow - (size_t)it * (size_t)(2048 * d) + 256);
    vv[32] = *(const f32x4*)(crow + (size_t)(TP + t - 128 * d) * 512 + 256);
    LDS_WAIT(); asm volatile("" ::: "memory");
    float sum = 0.f; f32x4 o = {0.f, 0.f, 0.f, 0.f};
#pragma unroll
    for (int it = 0; it < 33; ++it) {
        float e = __expf(sc_l[it < 32 ? 4 * it + kq : 128] - mx); if (it == 32 && kq != 0) e = 0.f;
        sum += e; o += vv[it] * e;
    }
    sum += __shfl_xor(sum, 16); sum += __shfl_xor(sum, 32);
#pragma unroll
    for (int e = 0; e < 4; ++e) { o[e] += __shfl_xor(o[e], 16); o[e] += __shfl_xor(o[e], 32); }
    const float inv = 1.0f / sum, lse = mx + __logf(sum);
    if (kq == 0) { v2u ov; ov.x = pk2(o[0] * inv, o[1] * inv); ov.y = pk2(o[2] * inv, o[3] * inv); *(v2u*)(AO + rowq * 768 + colq + 4 * dl) = ov; }
    if (F.lane == 0) LSE[rowq * 12 + G * 4 + hs] = lse;
    LDS_WAIT(); asm volatile("" ::: "memory");
}
constexpr unsigned CP_SLICE = 16384u, CP_NSLICES = 128u * 16u + 128u * 4u + 128u;
constexpr int CW_CPHEAD = 8192;
__device__ __forceinline__ void copy_slice(Frame& F, unsigned s) {
    const f32x4* src; f32x4* dst; unsigned per_b, k;
    if (s < 2048u) { const unsigned b = s >> 4; k = s & 15u; per_b = 2044u * 128u; src = (const f32x4*)F.inp(5) + (size_t)b * (2048 * 128) + 512; dst = (f32x4*)(F_OUT + O_W3S) + (size_t)b * (2048 * 128); }
    else if (s < 2560u) { const unsigned q = s - 2048u, b = q >> 2; k = q & 3u; per_b = 508u * 128u; src = (const f32x4*)F.inp(4) + (size_t)b * (512 * 128) + 512; dst = (f32x4*)(F_OUT + O_W2S) + (size_t)b * (512 * 128); }
    else { const unsigned b = s - 2560u; k = 0u; per_b = 124u * 128u; src = (const f32x4*)F.inp(3) + (size_t)b * (128 * 128) + 512; dst = (f32x4*)(F_OUT + O_W1S) + (size_t)b * (128 * 128); }
    const unsigned base = k * CP_SLICE + F.tid;
#pragma unroll 1
    for (int bt = 0; bt < 2; ++bt) {
        f32x4 v[16];
#pragma unroll
        for (int u = 0; u < 16; ++u) { const unsigned i = base + (unsigned)(bt * 16 + u) * 512u; if (i < per_b) v[u] = __builtin_nontemporal_load(src + i); }
#pragma unroll
        for (int u = 0; u < 16; ++u) { const unsigned i = base + (unsigned)(bt * 16 + u) * 512u; if (i < per_b) __builtin_nontemporal_store(v[u], dst + i); }
    }
}
__device__ __forceinline__ void copy_pull(Frame& F, int n) {
    LAS unsigned* sh = (LAS unsigned*)(F.lds + MISC_OFF) + 16;
    unsigned* head = (unsigned*)(F_WS + WS_CTL) + CW_CPHEAD;
    for (;;) {
        const int take = n > 0 ? n : 2;
        LDS_BARRIER();
        if (F.tid == 0) *sh = __hip_atomic_fetch_add(head, (unsigned)take, __ATOMIC_RELAXED, __HIP_MEMORY_SCOPE_AGENT);
        LDS_BARRIER();
        const unsigned s0 = *sh + (F.G == 256 ? CP_NSTATIC : 0u);
        if (s0 >= CP_NSLICES) break;
        for (unsigned s = s0; s < s0 + (unsigned)take && s < CP_NSLICES; ++s) copy_slice(F, s);
        if (n > 0) break;
    }
}
__device__ __forceinline__ void attn_phase(Frame& F) {
    { LAS float* bt = (LAS float*)(F.lds + RING_OFF + 72704);
      for (int i = F.tid; i < 12 * 129; i += 512) { const int hd = i / 129, j = i % 129; bt[hd * 132 + j] = F.inp(14)[t5_bucket(j << (2 * (hd >> 2))) * 12 + hd]; }
      __syncthreads(); }
    const int vcu = (F.G % 8 == 0) ? (F.bid % 8) * (F.G / 8) + F.bid / 8 : F.bid;
    for (int idx = vcu; idx < 1536; idx += F.G) {
        const int b = idx / 192, r = idx % 192, hs = r / 48, r2 = r % 48, g = r2 / 16, sub = r2 % 16;
        const int d = 1 << (2 * g), rho = g == 0 ? 0 : (g == 1 ? (sub >> 2) : sub), i0 = g == 0 ? 128 * sub : (g == 1 ? 128 * (sub & 3) : 0);
        const int it = (idx - vcu) / F.G; const bool ride = (F.G == 256) && it < 6;
        const CpBase cpb = copy_base(F, it < 4 ? (unsigned)F.bid : 1024u + ((unsigned)F.bid >> 1)); const int e0 = it < 4 ? it * 4096 : (F.bid & 1) * 8192 + (it - 4) * 4096;
        f32x4 cpv[8];
        if (ride) RIDE_LOAD(8, cpv, cpb, e0);
        attn_block(F, b, hs, g, rho, d, i0);
        if (ride) RIDE_STORE(8, cpv, cpb, e0);
    }
    LAS float* sc_l = (LAS float*)(F.lds + RING_OFF) + F.wave * 160; const LAS float* bias_t = (const LAS float*)(F.lds + RING_OFF + 72704);
    const int gw = F.bid * NWAVES + F.wave, ngw = F.G * NWAVES;
    for (int task = gw; task < MS * 12; task += ngw) attn_sample_task(F, task / (MS * 4), (task % (MS * 4)) >> 2, task & 3, sc_l, bias_t);
}
__device__ __forceinline__ void attn_merge_phase(Frame& F) {
    bf16* AO = WSP(bf16, WS_AO); const float* LSE = WSP(float, WS_LSE);
    const size_t nt = (size_t)F.G * 512;
    for (size_t i0 = (size_t)F.bid * 512 + F.tid; i0 < (size_t)M * 96; i0 += 8 * nt) {
        v4u w[8]; float l0[8], l1[8], l2[8];
#pragma unroll
        for (int u = 0; u < 8; ++u) { const size_t i = i0 + u * nt < (size_t)M * 96 ? i0 + u * nt : i0; const size_t row = i / 96; const int col = (int)(i % 96) * 8, hs = (col & 255) >> 6;
            w[u] = *(const v4u*)(AO + row * 768 + col); l0[u] = LSE[row * 12 + hs]; l1[u] = LSE[row * 12 + 4 + hs]; l2[u] = LSE[row * 12 + 8 + hs]; }
#pragma unroll
        for (int u = 0; u < 8; ++u) { const size_t i = i0 + u * nt; if (i < (size_t)M * 96) { const size_t row = i / 96; const int col = (int)(i % 96) * 8, g = col >> 8;
            const float mx = fmaxf(l0[u], fmaxf(l1[u], l2[u])), e0 = __expf(l0[u] - mx), e1 = __expf(l1[u] - mx), e2 = __expf(l2[u] - mx);
            const float al = (g == 0 ? e0 : (g == 1 ? e1 : e2)) / (e0 + e1 + e2);
            v4u o; o.x = pk2(bflo(w[u].x) * al, bfhi(w[u].x) * al); o.y = pk2(bflo(w[u].y) * al, bfhi(w[u].y) * al); o.z = pk2(bflo(w[u].z) * al, bfhi(w[u].z) * al); o.w = pk2(bflo(w[u].w) * al, bfhi(w[u].w) * al);
            *(v4u*)(AO + row * 768 + col) = o; } }
    }
}

__device__ __forceinline__ void rider_res(Frame& F, const pg8::Gemm g, const pg8::EpiRes E) {
    LAS float* part = (LAS float*)(F.lds + RING_OFF);
    const int fr = F.lane & 15, fq = F.lane >> 4, w = F.wave;
    const int kw = g.K >> 3, nks = kw >> 5;
    for (int piece = F.bid; piece < 256; piece += F.G) {
        const int rg = piece >> 4, cg = piece & 15;
        const bf16* Ab = g.A + (size_t)(MP + 32 * rg + fr) * g.lda + (size_t)g.a_pn * (cg >> 2) + (size_t)w * kw + 8 * fq;
        const bf16* Bb = g.Bt + (size_t)(64 * cg + fr) * g.ldb + (size_t)w * kw + 8 * fq;
        f32x4 acc[2][4];
#pragma unroll
        for (int rb = 0; rb < 2; ++rb)
#pragma unroll
            for (int cb = 0; cb < 4; ++cb) acc[rb][cb] = (f32x4){0.f, 0.f, 0.f, 0.f};
        for (int ks0 = 0; ks0 < nks; ks0 += 4) {
            bf16x8 a[4][2], b[4][4];
#pragma unroll
            for (int i = 0; i < 4; ++i) { const int ks = (ks0 + i < nks) ? ks0 + i : nks - 1;
#pragma unroll
                for (int rb = 0; rb < 2; ++rb) a[i][rb] = *(const bf16x8*)(Ab + (size_t)(16 * rb) * g.lda + 32 * ks);
#pragma unroll
                for (int cb = 0; cb < 4; ++cb) b[i][cb] = *(const bf16x8*)(Bb + (size_t)(16 * cb) * g.ldb + 32 * ks); }
#pragma unroll
            for (int i = 0; i < 4; ++i) if (ks0 + i < nks) {
#pragma unroll
                for (int rb = 0; rb < 2; ++rb)
#pragma unroll
                    for (int cb = 0; cb < 4; ++cb) acc[rb][cb] = MFMA16(a[i][rb], b[i][cb], acc[rb][cb]); }
        }
        __syncthreads();
#pragma unroll
        for (int rb = 0; rb < 2; ++rb)
#pragma unroll
            for (int cb = 0; cb < 4; ++cb) *(LAS f32x4*)(part + ((w * 8 + rb * 4 + cb) * 64 + F.lane) * 4) = acc[rb][cb];
        __syncthreads();
        const int rb = w >> 2, cb = w & 3;
        f32x4 v = {0.f, 0.f, 0.f, 0.f};
#pragma unroll
        for (int ww = 0; ww < 8; ++ww) v += *(const LAS f32x4*)(part + ((ww * 8 + w) * 64 + F.lane) * 4);
        const int col = 64 * cg + 16 * cb + fr;
        const float ps = E.pscale ? E.pscale[col] : 1.0f, ng = E.ngain ? E.ngain[col] : 0.f;
#pragma unroll
        for (int j = 0; j < 4; ++j) {
            const int rl = 16 * rb + 4 * fq + j, row = MP + 32 * rg + rl, bi = NBP + ((row - MP) >> 2);
            const float xn = E.xin_s[(size_t)row * D + col] + E.gate[(size_t)bi * MODLD + col] * ps * v[j];
            E.xout[(size_t)row * D + col] = xn;
            if (E.ngain) E.an[(size_t)row * D + col] = (bf16)(pk2(xn * (ng * (1.0f + E.nscale[(size_t)bi * MODLD + col])), 0.f) & 0xffffu);
            float ss = xn * xn;
            ss += __shfl_xor(ss, 1); ss += __shfl_xor(ss, 2); ss += __shfl_xor(ss, 4); ss += __shfl_xor(ss, 8);
            if (fr == 0) atomicAdd(E.rss + row, ss);
        }
    }
}

__device__ __forceinline__ float log_sigmoid(float z) { return fminf(z, 0.f) - log1pf(__expf(-fabsf(z))); }
__device__ __forceinline__ float log_sigmoid_fast(float z) { return fminf(z, 0.f) - __logf(1.0f + __expf(-fabsf(z))); }
__device__ __forceinline__ void gla_prep_phase(Frame& F) {
    LAS bf16* Qd_l = (LAS bf16*)(F.lds + RING_OFF);
    LAS bf16* Kd_l = (LAS bf16*)(F.lds + RING_OFF + 66560);
    const bf16* GQ = WSP(bf16, WS_GQ); const bf16* GK = WSP(bf16, WS_GK); const float* GD = WSP(float, WS_GD);
    bf16* QD = WSP(bf16, WS_QD); bf16* KET = WSP(bf16, WS_KET); bf16* ATT = WSP(bf16, WS_ATT); float* DEC = WSP(float, WS_DEC);
    const int col = F.tid;
    float wg[16];
#pragma unroll
    for (int j = 0; j < 16; ++j) wg[j] = F.inp(20)[j * 512 + col];
    const float bg = F.inp(21)[col];
    for (int cidx = F.bid; cidx < NBP * 32; cidx += F.G) {
        const size_t r0 = (size_t)cidx * 64;
        __syncthreads();
        float bc = 0.f;
        const bool ride = (F.G == 256) && cidx == F.bid; const CpBase cpb = copy_base(F, 256u + (unsigned)F.bid);
#define PREP_LOAD(S8, QV, KV, ZZ) do { \
            _Pragma("unroll") for (int e = 0; e < 8; ++e) { (QV)[e] = GQ[(r0 + 8 * (S8) + e) * 512 + col]; (KV)[e] = GK[(r0 + 8 * (S8) + e) * 512 + col]; } \
            _Pragma("unroll") for (int e = 0; e < 8; ++e) { const float* gd = GD + (r0 + 8 * (S8) + e) * 16; float z = bg; \
                _Pragma("unroll") for (int j = 0; j < 16; ++j) z += gd[j] * wg[j]; \
                (ZZ)[e] = z; } } while (0)
#define PREP_STEP(S8, QV, KV, ZZ) do { _Pragma("unroll") for (int e = 0; e < 8; ++e) { const int s = 8 * (S8) + e; \
                bc += log_sigmoid_fast((ZZ)[e]) * 0.0625f; \
                const float eb = __expf(bc), ieb = __builtin_amdgcn_rcpf(eb); \
                const unsigned qd = pk2(bf2f((QV)[e]) * eb, 0.f) & 0xffffu, kd = pk2(bf2f((KV)[e]) * ieb, 0.f) & 0xffffu; \
                QD[(r0 + s) * 512 + col] = (bf16)qd; Qd_l[s * 520 + col] = (bf16)qd; Kd_l[s * 520 + col] = (bf16)kd; } } while (0)
        unsigned short qa[8], ka[8], qb[8], kb[8]; float za[8], zb[8];
        PREP_LOAD(0, qa, ka, za);
#pragma unroll 1
        for (int s8 = 0; s8 < 8; s8 += 2) {
            f32x4 cpv[4];
            if (ride) RIDE_LOAD(4, cpv, cpb, s8 * 2048);
            PREP_LOAD(s8 + 1, qb, kb, zb);
            PREP_STEP(s8, qa, ka, za);
            if (ride) { RIDE_STORE(4, cpv, cpb, s8 * 2048); RIDE_LOAD(4, cpv, cpb, (s8 + 1) * 2048); }
            { const int s8n = s8 + 2 < 8 ? s8 + 2 : 7; PREP_LOAD(s8n, qa, ka, za); }
            PREP_STEP(s8 + 1, qb, kb, zb);
            if (ride) RIDE_STORE(4, cpv, cpb, (s8 + 1) * 2048);
        }
#undef PREP_STEP
#undef PREP_LOAD
        const float dec = __expf(bc);
        DEC[(size_t)cidx * 512 + col] = dec;
#pragma unroll
        for (int s8 = 0; s8 < 8; ++s8) {
            float ke[8];
#pragma unroll
            for (int e = 0; e < 8; ++e) ke[e] = bf2f(Kd_l[(8 * s8 + e) * 520 + col]) * dec;
            v4u w; w.x = pk2(ke[0], ke[1]); w.y = pk2(ke[2], ke[3]); w.z = pk2(ke[4], ke[5]); w.w = pk2(ke[6], ke[7]);
            *(v4u*)(KET + ((size_t)cidx * 512 + col) * 64 + 8 * s8) = w;
        }
        __syncthreads();
        int ln_ = F.lane; asm volatile("" : "+v"(ln_));
        const int fr = ln_ & 15, fq = ln_ >> 4;
        const int h = F.wave >> 1;
#pragma unroll
        for (int i = 0; i < 8; ++i) {
            const int sb = (F.wave & 1) * 2 + (i >> 2), tb = i & 3;
            f32x4 acc = {0.f, 0.f, 0.f, 0.f};
#pragma unroll
            for (int ks = 0; ks < 4; ++ks) {
                const bf16x8 a = *(const LAS bf16x8*)(Kd_l + (16 * sb + fr) * 520 + h * 128 + 32 * ks + 8 * fq);
                const bf16x8 bq = *(const LAS bf16x8*)(Qd_l + (16 * tb + fr) * 520 + h * 128 + 32 * ks + 8 * fq);
                acc = MFMA16(a, bq, acc);
            }
            int t = 16 * tb + fr; const int s0 = 16 * sb + 4 * fq;
            asm volatile("" : "+v"(t));
            v2u o; o.x = pk2(s0 + 0 <= t ? acc[0] : 0.f, s0 + 1 <= t ? acc[1] : 0.f); o.y = pk2(s0 + 2 <= t ? acc[2] : 0.f, s0 + 3 <= t ? acc[3] : 0.f);
            *(v2u*)(ATT + (((size_t)cidx * 4 + h) * 64 + t) * 64 + s0) = o;
        }
    }
}
__device__ __forceinline__ void gla_scan_phase(Frame& F) {
    const bf16* QD = WSP(bf16, WS_QD); const bf16* KET = WSP(bf16, WS_KET); const bf16* ATT = WSP(bf16, WS_ATT); const float* DEC = WSP(float, WS_DEC);
    const bf16* GV = WSP(bf16, WS_GV); float* GO = WSP(float, WS_GO);
    const int fr = F.lane & 15, fq = F.lane >> 4, w = F.wave, tb = w >> 1, cbo = w & 1;
    const int vcu = (F.G % 8 == 0) ? (F.bid % 8) * (F.G / 8) + F.bid / 8 : F.bid;
    for (int chain = vcu; chain < 256; chain += F.G) {
        const int b = chain >> 5, h = (chain >> 3) & 3, vs = chain & 7;
        f32x4 S[2]; S[0] = (f32x4){0.f, 0.f, 0.f, 0.f}; S[1] = (f32x4){0.f, 0.f, 0.f, 0.f};
        __syncthreads();
        bf16x8 qd[3][4], at[3][2], ke[3][2]; f32x4 dc[3]; v2u vv[3];
        const bool ride = (F.G == 256) && chain == vcu; const CpBase cb0 = copy_base(F, 768u + (unsigned)F.bid); f32x4 cpa[3];
#define SCAN_LOAD(CH, SET) do { const size_t ci_ = (size_t)b * 32 + (CH), rr_ = ci_ * 64; \
            _Pragma("unroll") for (int ks = 0; ks < 4; ++ks) qd[SET][ks] = *(const bf16x8*)(QD + (rr_ + 16 * tb + fr) * 512 + h * 128 + 32 * ks + 8 * fq); \
            _Pragma("unroll") for (int ks = 0; ks < 2; ++ks) { at[SET][ks] = *(const bf16x8*)(ATT + ((ci_ * 4 + h) * 64 + 16 * tb + fr) * 64 + 32 * ks + 8 * fq); \
                                             ke[SET][ks] = *(const bf16x8*)(KET + (ci_ * 512 + h * 128 + 16 * w + fr) * 64 + 32 * ks + 8 * fq); } \
            dc[SET] = *(const f32x4*)(DEC + ci_ * 512 + h * 128 + 16 * w + 4 * fq); \
            vv[SET] = *(const v2u*)(GV + (rr_ + (F.tid >> 3)) * 1024 + h * 256 + vs * 32 + (F.tid & 7) * 4); \
            if (ride) { const unsigned e_ = (unsigned)(CH) * 512u + (unsigned)F.tid; cpa[SET] = __builtin_nontemporal_load(cb0.src + (e_ < cb0.n ? e_ : cb0.n - 1u)); } } while (0)
#define SCAN_STEP(CH, SET) do { const size_t r0_ = ((size_t)b * 32 + (CH)) * 64; \
            LAS bf16* Vt_l = (LAS bf16*)(F.lds + RING_OFF + ((CH) & 1) * 16384);              \
            LAS bf16* St_l = (LAS bf16*)(F.lds + RING_OFF + ((CH) & 1) * 16384 + 4608);       \
            { const int s_ = F.tid >> 3, c4 = (F.tid & 7) * 4; const v2u v_ = vv[SET]; \
              Vt_l[(c4 + 0) * 72 + s_] = (bf16)(v_.x & 0xffffu); Vt_l[(c4 + 1) * 72 + s_] = (bf16)(v_.x >> 16); Vt_l[(c4 + 2) * 72 + s_] = (bf16)(v_.y & 0xffffu); Vt_l[(c4 + 3) * 72 + s_] = (bf16)(v_.y >> 16); } \
            _Pragma("unroll") for (int cb = 0; cb < 2; ++cb) { v2u sv; sv.x = pk2(S[cb][0], S[cb][1]); sv.y = pk2(S[cb][2], S[cb][3]); *(LAS v2u*)(St_l + (16 * cb + fr) * 136 + 16 * w + 4 * fq) = sv; } \
            LDS_BARRIER(); \
            f32x4 o = {0.f, 0.f, 0.f, 0.f}; \
            _Pragma("unroll") for (int ks = 0; ks < 4; ++ks) { const bf16x8 bs = *(const LAS bf16x8*)(St_l + (16 * cbo + fr) * 136 + 32 * ks + 8 * fq); o = MFMA16(qd[SET][ks], bs, o); } \
            _Pragma("unroll") for (int ks = 0; ks < 2; ++ks) { const bf16x8 bv = *(const LAS bf16x8*)(Vt_l + (16 * cbo + fr) * 72 + 32 * ks + 8 * fq); o = MFMA16(at[SET][ks], bv, o); } \
            _Pragma("unroll") for (int cb = 0; cb < 2; ++cb) { S[cb] = S[cb] * dc[SET]; \
                _Pragma("unroll") for (int ks = 0; ks < 2; ++ks) { const bf16x8 bv = *(const LAS bf16x8*)(Vt_l + (16 * cb + fr) * 72 + 32 * ks + 8 * fq); S[cb] = MFMA16(ke[SET][ks], bv, S[cb]); } } \
            _Pragma("unroll") for (int j = 0; j < 4; ++j) GO[(r0_ + 16 * tb + 4 * fq + j) * 1024 + h * 256 + vs * 32 + 16 * cbo + fr] = o[j]; \
            if (ride) { const unsigned e_ = (unsigned)(CH) * 512u + (unsigned)F.tid; if (e_ < cb0.n) __builtin_nontemporal_store(cpa[SET], cb0.dst + e_); } } while (0)
        SCAN_LOAD(0, 0); SCAN_LOAD(1, 1);
#pragma unroll 1
        for (int ch = 0; ch < 30; ch += 3) {
            SCAN_LOAD(ch + 2, 2);      SCAN_STEP(ch, 0);
            SCAN_LOAD(ch + 3, 0);      SCAN_STEP(ch + 1, 1);
            SCAN_LOAD(ch + 4, 1);      SCAN_STEP(ch + 2, 2);
        }
        SCAN_STEP(30, 0); SCAN_STEP(31, 1);
#undef SCAN_LOAD
#undef SCAN_STEP
        float* so = F_OUT + O_GLAP + ((size_t)(b * 4 + h) * 128) * 256 + vs * 32;
#pragma unroll
        for (int cb = 0; cb < 2; ++cb)
#pragma unroll
            for (int j = 0; j < 4; ++j) so[(size_t)(16 * w + 4 * fq + j) * 256 + 16 * cb + fr] = S[cb][j];
    }
}
__device__ __forceinline__ void gla_sample_phase(Frame& F) {
    LAS float* qd_l = (LAS float*)(F.lds + RING_OFF);
    LAS float* ke_l = qd_l + 512;
    LAS float* dec_l = ke_l + 512;
    LAS float* v_l = dec_l + 128;
    LAS float* aw_l = v_l + 1024;
    LAS float* op_l = aw_l + 32;
    const bf16* GQ = WSP(bf16, WS_GQ); const bf16* GK = WSP(bf16, WS_GK); const bf16* GV = WSP(bf16, WS_GV); const float* GD = WSP(float, WS_GD);
    float* GO = WSP(float, WS_GO);
    for (int uidx = F.bid; uidx < NBS * 4; uidx += F.G) {
        const int b = uidx >> 2, h = uidx & 3; const size_t rs0 = (size_t)MP + 4 * b;
        __syncthreads();
        if (F.tid < 128) {
            const int k = F.tid, col = h * 128 + k;
            float bt[4], qv[4], kv[4]; float bc = 0.f;
#pragma unroll
            for (int t = 0; t < 4; ++t) {
                float z = F.inp(21)[col];
#pragma unroll
                for (int j = 0; j < 16; ++j) z += GD[(rs0 + t) * 16 + j] * F.inp(20)[j * 512 + col];
                bc += log_sigmoid(z) * 0.0625f; bt[t] = bc;
                qv[t] = bf2f(GQ[(rs0 + t) * 512 + col]); kv[t] = bf2f(GK[(rs0 + t) * 512 + col]);
            }
#pragma unroll
            for (int t = 0; t < 4; ++t) { qd_l[t * 128 + k] = qv[t] * __expf(bt[t]); ke_l[t * 128 + k] = kv[t] * __expf(bt[3] - bt[t]); }
            dec_l[k] = __expf(bt[3]);
            int p = 0;
#pragma unroll
            for (int t = 0; t < 4; ++t)
#pragma unroll
                for (int s = 0; s <= t; ++s) { const float term = wave_sum(qv[t] * kv[s] * __expf(bt[t] - bt[s])); if (F.lane == 0) aw_l[F.wave * 16 + p] = term; ++p; }
        } else {
            for (int i = F.tid - 128; i < 1024; i += 384) { const int t = i >> 8, c = i & 255; v_l[i] = bf2f(GV[(rs0 + t) * 1024 + h * 256 + c]); }
        }
        __syncthreads();
        const int v4 = (F.tid & 63) * 4, kg = F.tid >> 6;
        const float* S0 = F.inp(6) + ((size_t)(b * 4 + h) * 128) * 256 + v4;
        float* Sf = F_OUT + O_GLAS + ((size_t)(b * 4 + h) * 128) * 256 + v4;
        const f32x4 v0 = *(const LAS f32x4*)(v_l + v4), v1 = *(const LAS f32x4*)(v_l + 256 + v4), v2 = *(const LAS f32x4*)(v_l + 512 + v4), v3 = *(const LAS f32x4*)(v_l + 768 + v4);
        f32x4 o0 = {0.f, 0.f, 0.f, 0.f}, o1 = o0, o2 = o0, o3 = o0;
        f32x4 sv[16];
#pragma unroll
        for (int kk = 0; kk < 16; ++kk) sv[kk] = __builtin_nontemporal_load((const f32x4*)(S0 + (size_t)(16 * kg + kk) * 256));
#pragma unroll
        for (int kk = 0; kk < 16; ++kk) {
            const int k = 16 * kg + kk; const f32x4 s0 = sv[kk];
            o0 += s0 * qd_l[k]; o1 += s0 * qd_l[128 + k]; o2 += s0 * qd_l[256 + k]; o3 += s0 * qd_l[384 + k];
            const f32x4 sf = s0 * dec_l[k] + ((v0 * ke_l[k] + v1 * ke_l[128 + k]) + (v2 * ke_l[256 + k] + v3 * ke_l[384 + k]));
            __builtin_nontemporal_store(sf, (f32x4*)(Sf + (size_t)k * 256));
        }
        *(LAS f32x4*)(op_l + (kg * 4 + 0) * 256 + v4) = o0; *(LAS f32x4*)(op_l + (kg * 4 + 1) * 256 + v4) = o1;
        *(LAS f32x4*)(op_l + (kg * 4 + 2) * 256 + v4) = o2; *(LAS f32x4*)(op_l + (kg * 4 + 3) * 256 + v4) = o3;
        __syncthreads();
        {
            const int t = F.tid >> 7, c = (F.tid & 127) * 2;
            f32x2 r = {0.f, 0.f};
#pragma unroll
            for (int q = 0; q < 8; ++q) r += *(const LAS f32x2*)(op_l + (q * 4 + t) * 256 + c);
            const int p0 = (t * (t + 1)) >> 1;
            for (int s = 0; s <= t; ++s) { const float a = aw_l[p0 + s] + aw_l[16 + p0 + s]; r += *(const LAS f32x2*)(v_l + s * 256 + c) * a; }
            *(f32x2*)(GO + (rs0 + t) * 1024 + h * 256 + c) = r;
        }
    }
}
__device__ __forceinline__ void gla_post_phase(Frame& F) {
    const float* GO = WSP(float, WS_GO); const bf16* GR = WSP(bf16, WS_GR); bf16* GA = WSP(bf16, WS_GA);
    const int nw = F.G * NWAVES;
    for (int idx0 = F.bid * NWAVES + F.wave; idx0 < M * 4; idx0 += 11 * nw) {
        f32x4 o[11]; v2u rw[11];
#pragma unroll
        for (int u = 0; u < 11; ++u) { const int idx = idx0 + u * nw < M * 4 ? idx0 + u * nw : idx0; const size_t off = (size_t)(idx >> 2) * 1024 + (idx & 3) * 256 + 4 * F.lane;
            o[u] = *(const f32x4*)(GO + off); rw[u] = *(const v2u*)(GR + off); }
#pragma unroll
        for (int u = 0; u < 11; ++u) { const int idx = idx0 + u * nw; if (idx < M * 4) { const size_t off = (size_t)(idx >> 2) * 1024 + (idx & 3) * 256 + 4 * F.lane;
            const float ss = wave_sum((o[u][0] * o[u][0] + o[u][1] * o[u][1]) + (o[u][2] * o[u][2] + o[u][3] * o[u][3]));
            const float rinv = __builtin_amdgcn_rsqf(ss * (1.0f / 256.0f) + EPS);
            const f32x4 gn = *(const f32x4*)(F.inp(22) + (idx & 3) * 256 + 4 * F.lane);
            const float r[4] = {bflo(rw[u].x), bfhi(rw[u].x), bflo(rw[u].y), bfhi(rw[u].y)};
            float y[4];
#pragma unroll
            for (int j = 0; j < 4; ++j) y[j] = (o[u][j] * rinv * gn[j]) * (r[j] / (1.0f + __expf(-r[j])));
            v2u w; w.x = pk2(y[0], y[1]); w.y = pk2(y[2], y[3]); *(v2u*)(GA + off) = w; } }
    }
}
__device__ __forceinline__ void final_norm_phase(Frame& F, int first_row) {
    const int nw = F.G * NWAVES;
    for (int row0 = first_row + F.bid * NWAVES + F.wave; row0 < M; row0 += 2 * nw) {
        f32x4 v[2][4];
#pragma unroll
        for (int u = 0; u < 2; ++u) { const int row = row0 + u * nw < M ? row0 + u * nw : row0; const float* xr = F_OUT + O_Y + (size_t)row * D;
#pragma unroll
            for (int j = 0; j < 4; ++j) v[u][j] = *(const f32x4*)(xr + 4 * F.lane + 256 * j); }
#pragma unroll
        for (int u = 0; u < 2; ++u) { const int row = row0 + u * nw; if (row < M) { float* xr = F_OUT + O_Y + (size_t)row * D; float s = 0.f;
#pragma unroll
            for (int j = 0; j < 4; ++j) s += (v[u][j][0] * v[u][j][0] + v[u][j][1] * v[u][j][1]) + (v[u][j][2] * v[u][j][2] + v[u][j][3] * v[u][j][3]);
            const float rinv = __builtin_amdgcn_rsqf(wave_sum(s) * (1.0f / D) + EPS);
#pragma unroll
            for (int j = 0; j < 4; ++j) { const f32x4 gn = *(const f32x4*)(F.inp(13) + 4 * F.lane + 256 * j); *(f32x4*)(xr + 4 * F.lane + 256 * j) = v[u][j] * rinv * gn; } } }
    }
}
#ifndef REP_MASK
#define REP_MASK 0
#endif
#define NREP(k) (1 + ((REP_MASK >> (k)) & 1))
#ifndef PH_MASK
#define PH_MASK 0xFFFF
#endif
#define EN_P0 ((PH_MASK >> 0) & 1)
#define EN_MOD ((PH_MASK >> 1) & 1)
#define EN_CB ((PH_MASK >> 2) & 1)
#define EN_POOL ((PH_MASK >> 3) & 1)
#define EN_QKV ((PH_MASK >> 4) & 1)
#define EN_ATTN ((PH_MASK >> 5) & 1)
#define EN_MERGE ((PH_MASK >> 6) & 1)
#define EN_GLAIN ((PH_MASK >> 7) & 1)
#define EN_PREP ((PH_MASK >> 8) & 1)
#define EN_SCAN ((PH_MASK >> 9) & 1)
#define EN_POST ((PH_MASK >> 10) & 1)
#define EN_MIX ((PH_MASK >> 11) & 1)
#define EN_FFNIN ((PH_MASK >> 12) & 1)
#define EN_FIX ((PH_MASK >> 13) & 1)
#define EN_FFND ((PH_MASK >> 14) & 1)
#define EN_FINAL ((PH_MASK >> 15) & 1)

struct CbOrder {
    int G, c;
    __device__ bool next(int i, pg8::Unit& u) const { const int L = i * G + c; if (L >= 110) return false; u.pn = L; u.pm = L < 88 ? L / 22 : (L < 97 ? 4 : 5); return true; }
    __device__ __forceinline__ void a_ready(const pg8::Unit&) const {}
    __device__ __forceinline__ void done(const pg8::Unit&) const {}
};
constexpr int NPH = 27;
struct Args { const float* in[28]; float* out; unsigned char* ws; int ph_lo, ph_hi; };
__global__ void __launch_bounds__(NWAVES * 64, 2) hybrid_fwd(Args args) {
    extern __shared__ __attribute__((aligned(16))) unsigned char lds[];
    Frame F;
    F.lds = (LAS unsigned char*)lds;
    F.tid = threadIdx.x; F.lane = F.tid & 63; F.wave = __builtin_amdgcn_readfirstlane(F.tid >> 6);
    F.G = gridDim.x; F.bid = blockIdx.x;
    F.ka = (const __attribute__((address_space(4))) unsigned char*)__builtin_amdgcn_kernarg_segment_ptr();
    F.out_g = (GAS float*)args.out; F.ws_g = (GAS unsigned char*)args.ws;
    for (int u = F.tid; u < (LDS_BYTES - LDSCTL_OFF) / 4; u += NWAVES * 64) ((LAS unsigned*)(F.lds + LDSCTL_OFF))[u] = 0u;
    __syncthreads();
    const int lo = args.ph_lo, hi = args.ph_hi;
    XcdBarrier bar; bar.bar = (unsigned*)(F_WS + WS_CTL) + CW_BAR; bar.x = 0; bar.st = nullptr;
    if (hi - lo > 1) bar = xcd_barrier_post((unsigned*)(F_WS + WS_CTL) + CW_BAR, (volatile LAS unsigned*)(F.lds + MISC_OFF) + 8, F.tid);
    int ph = 0;
#define RELAUNDER() do { asm volatile("" : "+s"(F.wave)); F.lane = fresh_lane(); F.tid = F.wave * 64 + F.lane; asm volatile("" : "+s"(F.ws_g), "+s"(F.out_g), "+s"(F.ka), "+s"(F.G), "+s"(F.bid)); } while (0)
#define IN() (lo <= ph && ph < hi)
#define REPBAR(r) (((r) > 0 && hi - lo > 1) ? (xcd_barrier(bar, F.tid), true) : true)
#define SEAM() do { if (lo <= ph && ph + 1 < hi) xcd_barrier(bar, F.tid); ++ph; RELAUNDER(); } while (0)
#define X (F_OUT + O_Y)
#define xs_in (F.inp(1) - (size_t)MP * D)
#define MOD WSP(float, WS_MOD)
#define RS0 WSP(float, WS_RSS)
#define RS1 (WSP(float, WS_RSS) + 262144)
#define ZERO_ROWSUMS(p) do { for (int i_ = F.bid * 512 + F.tid; i_ < M; i_ += F.G * 512) (p)[i_] = 0.f; } while (0)
#define CB WSP(float, WS_CB)
#define AN WSP(bf16, WS_AN)

    for (int rep_ = 0; rep_ < NREP(0); ++rep_) if (EN_P0 && IN() && REPBAR(rep_)) { p0_prologue(F); ZERO_ROWSUMS(RS0); ZERO_ROWSUMS(RS1); __syncthreads(); mod_direct_phase(F); }
    SEAM();
    for (int l = 0; l < 4; ++l) {
        const int kind = l % 3, jl = l / 3;
        if (kind == 0) {
            for (int rep_ = 0; rep_ < NREP(3); ++rep_) if (EN_POOL && IN() && REPBAR(rep_)) {
                if (EN_CB && l == 0) {
                    pg8::Gemm g{WSP(bf16, WS_SH), WSP(bf16, WS_WNF), 1024, 1024, 1024, 0}; CbOrder S{F.G, F.bid};
                    pg8::EpiCb E{CB};
                    pg8::gemm_phase<pg8::EpiCb, CbOrder, true, true>(F.lds + RING_OFF, g, S, E, F.wave);
                    __syncthreads();
                }
                pool_diff_phase(F, l, jl, (l == 0) ? F.inp(0) : X, (l == 0) ? xs_in : X, (l == 0) ? nullptr : RS1, EN_CB && l == 0 && F.G == 256);
            }
            SEAM();
        } else if (kind == 1) {
            for (int rep_ = 0; rep_ < NREP(4); ++rep_) if (EN_QKV && IN() && REPBAR(rep_)) {
                pg8::Gemm g{AN, WSP(bf16, WS_WNF) + (size_t)22528 * 1024, 1024, 1024, 1024, 0}; pg8::StaticOrder S; S.init(M, 2304, F.G, F.bid);
                pg8::EpiQkv E{RS1, CB + (size_t)4 * 256 * 5632, WSP(bf16, WS_QB), F_OUT, pg8::EpiRide{F.inp(5), F_OUT + O_W3S, 1332, (F.G == 256 && !rep_) ? 592 : 0}};
                pg8::gemm_phase<pg8::EpiQkv, pg8::StaticOrder, true, true>(F.lds + RING_OFF, g, S, E, F.wave);
                { const int nwg_ = 66 * 9, maxu_ = (nwg_ + F.G - 1) / F.G, myu_ = (nwg_ - F.bid + F.G - 1) / F.G; if (!rep_ && myu_ < maxu_) copy_pull(F, 2); }
            }
            SEAM();
            for (int rep_ = 0; rep_ < NREP(5); ++rep_) if (EN_ATTN && IN() && REPBAR(rep_)) attn_phase(F);
            SEAM();
            for (int rep_ = 0; rep_ < NREP(6); ++rep_) if (EN_MERGE && IN() && REPBAR(rep_)) attn_merge_phase(F);
            SEAM();
        } else {
            for (int rep_ = 0; rep_ < NREP(7); ++rep_) if (EN_GLAIN && IN() && REPBAR(rep_)) {
                pg8::Gemm g{AN, WSP(bf16, WS_WNF) + (size_t)24832 * 1024, 1024, 1024, 1024, 0}; pg8::StaticOrder S; S.init(M, 3328, F.G, F.bid);
                pg8::EpiGlaIn E{RS1, CB + (size_t)4 * 256 * 5632 + (size_t)256 * 2304, WSP(bf16, WS_GQ), WSP(float, WS_GD), pg8::EpiRide{F.inp(5), F_OUT + O_W3S, 1406, (F.G == 256 && !rep_) ? 856 : 0}};
                pg8::gemm_phase<pg8::EpiGlaIn, pg8::StaticOrder, true, true>(F.lds + RING_OFF, g, S, E, F.wave);
                { const int nwg_ = 66 * 13, maxu_ = (nwg_ + F.G - 1) / F.G, myu_ = (nwg_ - F.bid + F.G - 1) / F.G; if (!rep_ && myu_ < maxu_) copy_pull(F, 2); }
            }
            SEAM();
            for (int rep_ = 0; rep_ < NREP(8); ++rep_) if (EN_PREP && IN() && REPBAR(rep_)) { gla_prep_phase(F); gla_sample_phase(F); }
            SEAM();
            for (int rep_ = 0; rep_ < NREP(9); ++rep_) if (EN_SCAN && IN() && REPBAR(rep_)) gla_scan_phase(F);
            SEAM();
            for (int rep_ = 0; rep_ < NREP(10); ++rep_) if (EN_POST && IN() && REPBAR(rep_)) gla_post_phase(F);
            SEAM();
        }
        for (int rep_ = 0; rep_ < NREP(11); ++rep_) if (EN_MIX && IN() && REPBAR(rep_)) {
            pg8::StaticOrder S; S.init(MP, 1024, F.G, F.bid);
            const pg8::Gemm gm = kind == 0 ? pg8::Gemm{WSP(bf16, WS_DP), WSP(bf16, WS_WP) + (size_t)jl * 1024 * 256, 1024, 256, 256, 256}
                               : (kind == 1 ? pg8::Gemm{WSP(bf16, WS_AO), WSP(bf16, WS_WAO), 768, 768, 768, 0} : pg8::Gemm{WSP(bf16, WS_GA), WSP(bf16, WS_WGO), 1024, 1024, 1024, 0});
            pg8::EpiRes E{(l == 0) ? F.inp(0) : X, (l == 0) ? xs_in : X, rep_ ? WSP(float, WS_DUMMY) : X, MOD + l * 6144 + 2 * 1024, kind == 0 ? F.inp(16) + (size_t)jl * D : nullptr,
                          F.inp(12) + (size_t)(l * 2 + 1) * D, MOD + l * 6144 + 4 * 1024, rep_ ? WSP(bf16, WS_DUMMY2) : AN, rep_ ? WSP(float, WS_DUMMY3) : RS0, nullptr, nullptr};
            if (!rep_) ZERO_ROWSUMS(RS1);
            pg8::gemm_phase<pg8::EpiRes, pg8::StaticOrder, true, true>(F.lds + RING_OFF, gm, S, E, F.wave);
            rider_res(F, gm, E);
        }
        SEAM();
        for (int rep_ = 0; rep_ < NREP(12); ++rep_) if (EN_FFNIN && IN() && REPBAR(rep_)) {
            pg8::Gemm g{AN, WSP(bf16, WS_WNF) + (size_t)l * 5632 * 1024, 1024, 1024, 1024, 0}; pg8::StaticOrder S; S.init(M, 5632, F.G, F.bid);
            pg8::EpiFfnIn E{RS0, CB + (size_t)l * 256 * 5632, F.inp(25) + (size_t)l * 3 * DFF, F.inp(26) + (size_t)l * DFF, F.inp(7) + (size_t)l * NBS * 2 * DFF,
                            WSP(bf16, WS_ACT), WSP(float, WS_HG), WSP(float, WS_HU), WSP(float, WS_TG), F_OUT + O_CONVP + (size_t)l * NBP * 2 * DFF, F_OUT + O_CONVS + (size_t)l * NBS * 2 * DFF,
                            pg8::EpiRide{F.inp(5), F_OUT + O_W3S, 1152 + 45 * l, (F.G == 256 && !rep_) ? 1440 : 0}};
            pg8::gemm_phase<pg8::EpiFfnIn, pg8::StaticOrder, true, true>(F.lds + RING_OFF, g, S, E, F.wave);
                { const int nwg_ = 66 * 22, maxu_ = (nwg_ + F.G - 1) / F.G, myu_ = (nwg_ - F.bid + F.G - 1) / F.G; if (!rep_ && myu_ < maxu_) copy_pull(F, 2); }
        }
        SEAM();
        for (int rep_ = 0; rep_ < NREP(13); ++rep_) if (EN_FIX && IN() && REPBAR(rep_)) ffn_fixup_phase(F, l);
        SEAM();
        for (int rep_ = 0; rep_ < NREP(14); ++rep_) if (EN_FFND && IN() && REPBAR(rep_)) {
            pg8::Gemm g{WSP(bf16, WS_ACT), WSP(bf16, WS_WD) + (size_t)l * 1024 * DFF, DFF, DFF, DFF, 0}; pg8::StaticOrder S; S.init(MP, 1024, F.G, F.bid);
            pg8::EpiRes E{X, X, rep_ ? WSP(float, WS_DUMMY) : X, MOD + l * 6144 + 5 * 1024, nullptr,
                          (l < 3 && (l + 1) % 3 != 0) ? F.inp(12) + (size_t)((l + 1) * 2) * D : nullptr, MOD + (l + 1) * 6144 + 1 * 1024, rep_ ? WSP(bf16, WS_DUMMY2) : AN, rep_ ? WSP(float, WS_DUMMY3) : RS1,
                          (l == 3 && !rep_ && F.G == 256) ? F.inp(13) : nullptr, (unsigned*)(F_WS + WS_CTL) + CW_FINCNT};
            if (!rep_) ZERO_ROWSUMS(RS0);
            pg8::gemm_phase<pg8::EpiRes, pg8::StaticOrder, true, true>(F.lds + RING_OFF, g, S, E, F.wave);
            rider_res(F, g, E);
        }
        SEAM();
    }
    for (int rep_ = 0; rep_ < NREP(15); ++rep_) if (EN_FINAL && IN() && REPBAR(rep_)) { final_norm_phase(F, F.G == 256 ? MP : 0); copy_pull(F, 0); }
#undef X
#undef xs_in
#undef MOD
#undef RS0
#undef RS1
#undef CB
#undef AN
#undef IN
#undef SEAM
}

extern "C" void kernel_launch(void* const* d_in, const int* in_sizes, int n_in, void* d_out, int out_size, void* d_ws, size_t ws_size, hipStream_t stream) {
    static int grid = 0;
    if (grid == 0) {
        if (n_in != 28 || (size_t)out_size != O_END || ws_size < WS_END) { fprintf(stderr, "kernel_launch: unexpected shapes: n_in %d out %d (want %zu) ws %zu (want %zu)\n", n_in, out_size, (size_t)O_END, ws_size, (size_t)WS_END); grid = -1; return; }
        int dev = 0, cus = 0, per_cu = 0;
        if (hipGetDevice(&dev) != hipSuccess || hipDeviceGetAttribute(&cus, hipDeviceAttributeMultiprocessorCount, dev) != hipSuccess) { fprintf(stderr, "kernel_launch: device query failed\n"); grid = -1; return; }
        if (hipFuncSetAttribute((const void*)hybrid_fwd, hipFuncAttributeMaxDynamicSharedMemorySize, LDS_BYTES) != hipSuccess) { fprintf(stderr, "kernel_launch: hipFuncSetAttribute failed\n"); grid = -1; return; }
        if (hipOccupancyMaxActiveBlocksPerMultiprocessor(&per_cu, (const void*)hybrid_fwd, NWAVES * 64, LDS_BYTES) != hipSuccess || per_cu < 1)
            fprintf(stderr, "kernel_launch: note: occupancy query reports %d workgroups per CU\n", per_cu);
        (void)hipGetLastError();
        grid = cus;
    }
    if (grid < 0) return;
    if (hipMemsetAsync((char*)d_ws + WS_CTL, 0, CTL_ZERO_BYTES, stream) != hipSuccess) { fprintf(stderr, "kernel_launch: memset failed\n"); return; }
    Args a{};
    for (int i = 0; i < 28; ++i) a.in[i] = (const float*)d_in[i];
    a.out = (float*)d_out; a.ws = (unsigned char*)d_ws;
#if MK_LAUNCH_PER_PHASE
    for (int p = 0; p < NPH; ++p) { a.ph_lo = p; a.ph_hi = p + 1; hipLaunchKernelGGL(hybrid_fwd, dim3(grid), dim3(NWAVES * 64), LDS_BYTES, stream, a); }
#else
    a.ph_lo = 0; a.ph_hi = NPH; hipLaunchKernelGGL(hybrid_fwd, dim3(grid), dim3(NWAVES * 64), LDS_BYTES, stream, a);
#endif
    const hipError_t le = hipPeekAtLastError();
    if (le != hipSuccess) fprintf(stderr, "kernel_launch: launch failed: %s\n", hipGetErrorName(le));
}
```
